# Optimizing an MI355X kernel written in HIP

```python
import math
import jax, jax.numpy as jnp
from jax import lax
import numpy as np

D_MODEL = 1024
BATCH = 8
SEQ = 4096
DEPTH = 1

A_HEADS = 8
A_HEAD_DIM = 64
A_WIDTH = A_HEADS * A_HEAD_DIM
MOBA_BLOCK = 256
MOBA_TOPK = 3
MOBA_Q_CHUNK = 32
B_HEADS = 8
B_NOPE = 64
B_ROPE = 32
B_V = 64
B_WIDTH = B_HEADS * B_V
Q_LORA = 256
KV_LORA = 128
MLA_Q_BLOCK = 128
PEER_HEADS = 8
PEER_NKEYS = 128
PEER_EXPERTS = PEER_NKEYS * PEER_NKEYS
PEER_HALF = 128
PEER_QDIM = 2 * PEER_HALF
PEER_TOPK = 16
PEER_TOKEN_CHUNK = 128
ROPE_THETA = 10000.0
RMS_EPS = 1e-6
IN_WIDTHS = (A_WIDTH, A_WIDTH, A_WIDTH, Q_LORA, KV_LORA, B_ROPE, D_MODEL, D_MODEL)
IN_TOTAL = 3 * A_WIDTH + Q_LORA + KV_LORA + B_ROPE + 2 * D_MODEL

kernel_name = "hybrid_moba_mla_peer_block"


def rms_norm(x, g):
    xf = x.astype(jnp.float32)
    y = xf * lax.rsqrt(jnp.mean(xf * xf, axis=-1, keepdims=True) + RMS_EPS)
    return (y * g.astype(jnp.float32)).astype(x.dtype)


def rope_tables(positions, dim, dtype):
    inv_freq = ROPE_THETA ** (-jnp.arange(0, dim, 2, dtype=jnp.float32) / dim)
    ang = positions.astype(jnp.float32)[..., None] * inv_freq
    return jnp.cos(ang)[:, :, None, :].astype(dtype), jnp.sin(ang)[:, :, None, :].astype(dtype)


def apply_rope(x, cos, sin):
    x1, x2 = jnp.split(x, 2, axis=-1)
    return jnp.concatenate([x1 * cos - x2 * sin, x2 * cos + x1 * sin], axis=-1)


def moba_attention(q, k, v):
    B, S, H, dh = q.shape
    nb = -(-S // MOBA_BLOCK)
    pad = nb * MOBA_BLOCK - S
    k_eff = min(MOBA_TOPK, nb)
    scale = 1.0 / math.sqrt(dh)
    qt = q.transpose(0, 2, 1, 3)
    kt = jnp.pad(k.transpose(0, 2, 1, 3), ((0, 0), (0, 0), (0, pad), (0, 0)))
    vt = jnp.pad(v.transpose(0, 2, 1, 3), ((0, 0), (0, 0), (0, pad), (0, 0)))
    kb = kt.reshape(B, H, nb, MOBA_BLOCK, dh)
    vb = vt.reshape(B, H, nb, MOBA_BLOCK, dh)
    k_mean = jnp.mean(kb.astype(jnp.float32), axis=3)
    b_ix = jnp.arange(B)[:, None, None, None]
    h_ix = jnp.arange(H)[None, :, None, None]
    n_chunks = S // MOBA_Q_CHUNK

    def chunk(ci):
        start = ci * MOBA_Q_CHUNK
        blk = start // MOBA_BLOCK
        qc = lax.dynamic_slice_in_dim(qt, start, MOBA_Q_CHUNK, axis=2)
        gate = jnp.einsum('bhqd,bhnd->bhqn', qc.astype(jnp.float32), k_mean)
        gate = jnp.where(jnp.arange(nb) < blk, gate, -jnp.inf)
        _, sel = lax.top_k(gate, k_eff)
        sel_valid = jnp.arange(k_eff) < blk
        k_sel = kb[b_ix, h_ix, sel]
        v_sel = vb[b_ix, h_ix, sel]
        s_sel = jnp.einsum('bhqd,bhqtkd->bhqtk', qc, k_sel).astype(jnp.float32) * scale
        s_sel = jnp.where(sel_valid[:, None], s_sel, -jnp.inf)
        s_sel = s_sel.reshape(B, H, MOBA_Q_CHUNK, k_eff * MOBA_BLOCK)
        k_own = lax.dynamic_index_in_dim(kb, blk, axis=2, keepdims=False)
        v_own = lax.dynamic_index_in_dim(vb, blk, axis=2, keepdims=False)
        s_own = jnp.einsum('bhqd,bhkd->bhqk', qc, k_own).astype(jnp.float32) * scale
        q_pos = start + jnp.arange(MOBA_Q_CHUNK)
        k_pos = blk * MOBA_BLOCK + jnp.arange(MOBA_BLOCK)
        s_own = jnp.where(k_pos[None, :] <= q_pos[:, None], s_own, -jnp.inf)
        p = jax.nn.softmax(jnp.concatenate([s_sel, s_own], axis=-1), axis=-1).astype(v.dtype)
        p_sel = p[..., :k_eff * MOBA_BLOCK].reshape(B, H, MOBA_Q_CHUNK, k_eff, MOBA_BLOCK)
        p_own = p[..., k_eff * MOBA_BLOCK:]
        return (jnp.einsum('bhqtk,bhqtkd->bhqd', p_sel, v_sel)
                + jnp.einsum('bhqk,bhkd->bhqd', p_own, v_own))

    out = lax.map(chunk, jnp.arange(n_chunks))
    return out.transpose(1, 0, 3, 2, 4).reshape(B, S, H * dh)


def causal_attention_blocks(q, k, v, scale):
    B, H, S, _ = q.shape
    dv = v.shape[-1]
    k_pos = jnp.arange(S)

    def block(bi):
        qb = lax.dynamic_slice_in_dim(q, bi * MLA_Q_BLOCK, MLA_Q_BLOCK, axis=2)
        s = jnp.einsum('bhqd,bhkd->bhqk', qb, k).astype(jnp.float32) * scale
        q_pos = bi * MLA_Q_BLOCK + jnp.arange(MLA_Q_BLOCK)
        s = jnp.where(k_pos[None, :] <= q_pos[:, None], s, -jnp.inf)
        p = jax.nn.softmax(s, axis=-1).astype(v.dtype)
        return jnp.einsum('bhqk,bhkd->bhqd', p, v)

    out = lax.map(block, jnp.arange(S // MLA_Q_BLOCK))
    return out.transpose(1, 0, 3, 2, 4).reshape(B, S, H * dv)


def mla_attention(c_q, c_kv, k_pe, q_norm_g, w_q_up, kv_norm_g, w_kv_up, cos_b, sin_b):
    B, S, _ = c_q.shape
    q = (rms_norm(c_q, q_norm_g) @ w_q_up).reshape(B, S, B_HEADS, B_NOPE + B_ROPE)
    q_nope, q_pe = q[..., :B_NOPE], q[..., B_NOPE:]
    q_pe = apply_rope(q_pe, cos_b, sin_b)
    kv = (rms_norm(c_kv, kv_norm_g) @ w_kv_up).reshape(B, S, B_HEADS, B_NOPE + B_V)
    k_nope, v = kv[..., :B_NOPE], kv[..., B_NOPE:]
    k_pe = apply_rope(k_pe[:, :, None, :], cos_b, sin_b)
    k_pe = jnp.broadcast_to(k_pe, (B, S, B_HEADS, B_ROPE))
    q_full = jnp.concatenate([q_nope, q_pe], axis=-1).transpose(0, 2, 1, 3)
    k_full = jnp.concatenate([k_nope, k_pe], axis=-1).transpose(0, 2, 1, 3)
    v = v.transpose(0, 2, 1, 3)
    return causal_attention_blocks(q_full, k_full, v, 1.0 / math.sqrt(B_NOPE + B_ROPE))


def peer_ffn(h, w_query, sub_keys_1, sub_keys_2, expert_u, expert_v):
    B, S, D = h.shape
    T = B * S
    hc = h.reshape(T // PEER_TOKEN_CHUNK, PEER_TOKEN_CHUNK, D)

    def chunk(xc):
        q = (xc @ w_query).reshape(PEER_TOKEN_CHUNK, PEER_HEADS, 2, PEER_HALF)
        s1 = jnp.einsum('thd,hnd->thn', q[:, :, 0], sub_keys_1).astype(jnp.float32)
        s2 = jnp.einsum('thd,hnd->thn', q[:, :, 1], sub_keys_2).astype(jnp.float32)
        v1, i1 = lax.top_k(s1, PEER_TOPK)
        v2, i2 = lax.top_k(s2, PEER_TOPK)
        cand = (v1[..., :, None] + v2[..., None, :]).reshape(PEER_TOKEN_CHUNK, PEER_HEADS, PEER_TOPK * PEER_TOPK)
        cand_idx = (i1[..., :, None] * PEER_NKEYS + i2[..., None, :]).reshape(PEER_TOKEN_CHUNK, PEER_HEADS, PEER_TOPK * PEER_TOPK)
        best, pos = lax.top_k(cand, PEER_TOPK)
        idx = jnp.take_along_axis(cand_idx, pos, axis=-1)
        g = jax.nn.softmax(best, axis=-1)
        u = expert_u[idx]
        act = jax.nn.gelu(jnp.einsum('td,thkd->thk', xc, u).astype(jnp.float32), approximate=False)
        w = (g * act).astype(h.dtype)
        return jnp.einsum('thk,thkd->td', w, expert_v[idx])

    return lax.map(chunk, hc).reshape(B, S, D)


def setup_inputs(seed: int = 0) -> dict:
    key = jax.random.key(seed)
    ks = jax.random.split(key, 20)
    f32 = jnp.float32
    L = DEPTH

    def nrm(k, shape, scale):
        return jax.random.normal(k, shape, f32) * scale

    def gain(k, shape):
        return 1.0 + 0.02 * jax.random.normal(k, shape, f32)

    x = jax.random.normal(ks[0], (BATCH, SEQ, D_MODEL), f32)
    positions = jnp.broadcast_to(jnp.arange(SEQ, dtype=jnp.int32), (BATCH, SEQ))
    return {
        "x": x,
        "positions": positions,
        "mix_norm_g": gain(ks[1], (L, D_MODEL)),
        "w_in": nrm(ks[2], (L, D_MODEL, IN_TOTAL), D_MODEL ** -0.5),
        "q_norm_g": gain(ks[3], (L, Q_LORA)),
        "w_q_up": nrm(ks[4], (L, Q_LORA, B_HEADS * (B_NOPE + B_ROPE)), Q_LORA ** -0.5),
        "kv_norm_g": gain(ks[5], (L, KV_LORA)),
        "w_kv_up": nrm(ks[6], (L, KV_LORA, B_HEADS * (B_NOPE + B_V)), KV_LORA ** -0.5),
        "w_branch_a": nrm(ks[7], (L, A_WIDTH, D_MODEL), A_WIDTH ** -0.5),
        "w_branch_b": nrm(ks[8], (L, B_WIDTH, D_MODEL), B_WIDTH ** -0.5),
        "w_out": nrm(ks[9], (L, D_MODEL, D_MODEL), D_MODEL ** -0.5),
        "ffn_norm_g": gain(ks[10], (L, D_MODEL)),
        "w_peer_query": nrm(ks[11], (L, D_MODEL, PEER_HEADS * PEER_QDIM), D_MODEL ** -0.5),
        "peer_sub_keys_1": nrm(ks[12], (L, PEER_HEADS, PEER_NKEYS, PEER_HALF), PEER_HALF ** -0.5),
        "peer_sub_keys_2": nrm(ks[13], (L, PEER_HEADS, PEER_NKEYS, PEER_HALF), PEER_HALF ** -0.5),
        "peer_expert_u": nrm(ks[14], (L, PEER_EXPERTS, D_MODEL), D_MODEL ** -0.5),
        "peer_expert_v": nrm(ks[15], (L, PEER_EXPERTS, D_MODEL), (PEER_HEADS * PEER_TOPK) ** -0.5),
        "final_norm_g": gain(ks[16], (D_MODEL,)),
    }


def reference(x, positions, mix_norm_g, w_in, q_norm_g, w_q_up, kv_norm_g, w_kv_up,
              w_branch_a, w_branch_b, w_out, ffn_norm_g, w_peer_query, peer_sub_keys_1,
              peer_sub_keys_2, peer_expert_u, peer_expert_v, final_norm_g):
    B, S, _ = x.shape
    cos_a, sin_a = rope_tables(positions, A_HEAD_DIM, x.dtype)
    cos_b, sin_b = rope_tables(positions, B_ROPE, x.dtype)
    splits = [sum(IN_WIDTHS[:i + 1]) for i in range(len(IN_WIDTHS) - 1)]
    for layer in range(DEPTH):
        h = rms_norm(x, mix_norm_g[layer])
        proj = h @ w_in[layer]
        q_a, k_a, v_a, c_q, c_kv, k_pe, gate_a, gate_b = jnp.split(proj, splits, axis=-1)
        q_a = apply_rope(q_a.reshape(B, S, A_HEADS, A_HEAD_DIM), cos_a, sin_a)
        k_a = apply_rope(k_a.reshape(B, S, A_HEADS, A_HEAD_DIM), cos_a, sin_a)
        v_a = v_a.reshape(B, S, A_HEADS, A_HEAD_DIM)
        y_a = moba_attention(q_a, k_a, v_a)
        y_b = mla_attention(c_q, c_kv, k_pe, q_norm_g[layer], w_q_up[layer],
                            kv_norm_g[layer], w_kv_up[layer], cos_b, sin_b)
        merged = (jax.nn.sigmoid(gate_a) * (y_a @ w_branch_a[layer])
                  + jax.nn.sigmoid(gate_b) * (y_b @ w_branch_b[layer]))
        x = x + merged @ w_out[layer]
        x = x + peer_ffn(rms_norm(x, ffn_norm_g[layer]), w_peer_query[layer],
                         peer_sub_keys_1[layer], peer_sub_keys_2[layer],
                         peer_expert_u[layer], peer_expert_v[layer])
    return rms_norm(x, final_norm_g)
```

```cpp
#include <hip/hip_runtime.h>
#include <hip/hip_cooperative_groups.h>
#include <cstdio>
#include <cstdint>
namespace cg = cooperative_groups;

#ifndef MK_COOP
#define MK_COOP 1
#endif

typedef unsigned short bf16_t;
typedef short bf16x8 __attribute__((ext_vector_type(8)));
typedef float f32x4 __attribute__((ext_vector_type(4)));
typedef float f32x16 __attribute__((ext_vector_type(16)));
typedef unsigned u32x4 __attribute__((ext_vector_type(4)));
typedef unsigned u32x2 __attribute__((ext_vector_type(2)));
typedef __bf16 bf16x2_t __attribute__((ext_vector_type(2)));

#define DI __device__ __forceinline__

constexpr int T = 32768, SEQ = 4096, DM = 1024;
constexpr int NTHR = 512, NWV = 8;
constexpr int XB_LD = 1088;
constexpr float RMS_EPS = 1e-6f;
constexpr float LOG2E = 1.4426950408889634f;
constexpr float QS_A = 0.125f * LOG2E;
constexpr float QS_B = 0.10206207261596577f * LOG2E;

constexpr size_t MiB = 1ull << 20;
constexpr size_t OFF_WTIN = 0;
constexpr size_t OFF_WTQUP = 8 * MiB;
constexpr size_t OFF_WTKVUP = 8 * MiB + 512 * 1024;
constexpr size_t OFF_WTA = 9 * MiB;
constexpr size_t OFF_WTB = 10 * MiB;
constexpr size_t OFF_WTOUT = 11 * MiB;
constexpr size_t OFF_WTPQ = 13 * MiB;
constexpr size_t OFF_KEYS = 17 * MiB;
constexpr size_t OFF_COSA = 18 * MiB;
constexpr size_t OFF_SINA = 22 * MiB;
constexpr size_t OFF_COSB = 26 * MiB;
constexpr size_t OFF_SINB = 28 * MiB;
constexpr size_t OFF_RINV1 = 30 * MiB;
constexpr size_t OFF_RINV2 = 30 * MiB + 128 * 1024;
constexpr size_t OFF_KMEAN = 30 * MiB + 256 * 1024;
constexpr size_t OFF_CTR = 30 * MiB + 512 * 1024;
constexpr size_t OFF_SSQ2 = OFF_CTR + 32 * 1024;
constexpr size_t CTR_MEMSET_BYTES = 160 * 1024;
constexpr size_t R1 = 31 * MiB;
constexpr size_t OFF_XB = R1;
constexpr size_t OFF_QN = R1;
constexpr size_t OFF_KN = R1 + 32 * MiB;
constexpr size_t OFF_VBT = R1 + 64 * MiB;
constexpr size_t OFF_QPE = R1 + 96 * MiB;
constexpr size_t R2 = 143 * MiB;
constexpr size_t OFF_QA = R2;
constexpr size_t OFF_KA = R2 + 32 * MiB;
constexpr size_t OFF_VAT = R2 + 64 * MiB;
constexpr size_t OFF_CQ = R2 + 96 * MiB;
constexpr size_t OFF_CKV = R2 + 112 * MiB;
constexpr size_t OFF_KPE = R2 + 120 * MiB;
constexpr size_t OFF_GA = 265 * MiB;
constexpr size_t OFF_GB = 329 * MiB;
constexpr size_t OFF_YA = 393 * MiB;
constexpr size_t OFF_YB = 425 * MiB;
constexpr size_t OFF_MERGED = R2;
constexpr size_t OFF_X2 = OFF_GA;
constexpr size_t OFF_X2B = OFF_YA;
constexpr size_t OFF_QP = R1;
constexpr size_t OFF_PIDX = R1 + 128 * MiB;
constexpr size_t OFF_PG = R1 + 144 * MiB;
constexpr size_t OFF_UB = R1 + 160 * MiB;
constexpr size_t OFF_VB = R1 + 192 * MiB;
constexpr size_t OFF_VB8 = R1 + 176 * MiB;
static_assert(OFF_VB + 32 * MiB <= OFF_GA, "overlay");

struct Params {
    const float* x; const int* pos; const float* mix_g; const float* w_in; const float* qn_g; const float* w_qup;
    const float* kvn_g; const float* w_kvup; const float* w_a; const float* w_b; const float* w_out; const float* ffn_g;
    const float* w_pq; const float* keys1; const float* keys2; const float* eu; const float* ev; const float* fin_g;
    float* out; char* ws;
};

typedef float f32x2 __attribute__((ext_vector_type(2)));
DI unsigned pk_bf16(float lo, float hi) { const f32x2 v = {lo, hi}; return __builtin_bit_cast(unsigned, __builtin_convertvector(v, bf16x2_t)); }
DI bf16_t f2bf(float x) { return (bf16_t)(pk_bf16(x, x) & 0xffffu); }
DI float bf_lo(unsigned w) { return __uint_as_float(w << 16); }
DI float bf_hi(unsigned w) { return __uint_as_float(w & 0xffff0000u); }
DI int tid_fresh() { int t = threadIdx.x; asm volatile("" : "+v"(t)); return t; }
DI float swap_add32(float a, float b) { const u32x2 r = __builtin_amdgcn_permlane32_swap(__float_as_uint(a), __float_as_uint(b), false, false); return __uint_as_float(r[0]) + __uint_as_float(r[1]); }
DI float swap_add16(float a, float b) { const u32x2 r = __builtin_amdgcn_permlane16_swap(__float_as_uint(a), __float_as_uint(b), false, false); return __uint_as_float(r[0]) + __uint_as_float(r[1]); }
template <int CTRL> DI float dpp_get(float v) { return __int_as_float(__builtin_amdgcn_update_dpp(0, __float_as_int(v), CTRL, 0xf, 0xf, false)); }
DI float wave_sum(float v) {
#pragma unroll
    for (int o = 32; o >= 1; o >>= 1) v += __shfl_xor(v, o);
    return v;
}
DI float fdot2(unsigned a, unsigned b, float c) { return __builtin_amdgcn_fdot2_f32_bf16(__builtin_bit_cast(bf16x2_t, a), __builtin_bit_cast(bf16x2_t, b), c, false); }
DI float dot8(const u32x4& a, const u32x4& b, float c) { c = fdot2(a.x, b.x, c); c = fdot2(a.y, b.y, c); c = fdot2(a.z, b.z, c); c = fdot2(a.w, b.w, c); return c; }
DI f32x2 fp8lo(unsigned w) { return __builtin_amdgcn_cvt_pk_f32_fp8((int)w, false); }
DI f32x2 fp8hi(unsigned w) { return __builtin_amdgcn_cvt_pk_f32_fp8((int)w, true); }
DI unsigned pack_fp8x4(float a, float b, float c, float d) { int r = 0; r = __builtin_amdgcn_cvt_pk_fp8_f32(a, b, r, false); r = __builtin_amdgcn_cvt_pk_fp8_f32(c, d, r, true); return (unsigned)r; }
constexpr float U8_SCALE = 64.0f, V8_SCALE = 16.0f;
#define MFMA16(a, b, c) __builtin_amdgcn_mfma_f32_16x16x32_bf16((a), (b), (c), 0, 0, 0)
#define MFMA32(a, b, c) __builtin_amdgcn_mfma_f32_32x32x16_bf16((a), (b), (c), 0, 0, 0)

template <class F>
DI void transpose_w(const float* __restrict__ W, int ldw, int K, int Nd, const float* __restrict__ g, bf16_t* __restrict__ Wt, F srccol, int gw, int nw, int lane) {
    const int nbn = Nd / 64, ntask = nbn * (K / 32);
    for (int task = gw; task < ntask; task += nw) {
        const int nb = task % nbn, kb = task / nbn;
        const int nd = nb * 64 + lane, sc = srccol(nd);
        unsigned w[16];
#pragma unroll
        for (int j = 0; j < 16; ++j) {
            const int k = kb * 32 + 2 * j;
            float a = 0.f, b = 0.f;
            if (sc >= 0) { a = W[(size_t)k * ldw + sc]; b = W[(size_t)(k + 1) * ldw + sc]; if (g) { a *= g[k]; b *= g[k + 1]; } }
            w[j] = pk_bf16(a, b);
        }
        u32x4* dst = (u32x4*)(Wt + (size_t)nd * K + kb * 32);
#pragma unroll
        for (int j = 0; j < 4; ++j) dst[j] = (u32x4){w[4 * j], w[4 * j + 1], w[4 * j + 2], w[4 * j + 3]};
    }
}

DI void phase_prep(const Params& P) {
    char* ws = P.ws;
    const int tid = tid_fresh(), lane = tid & 63;
    const int gw = blockIdx.x * NWV + (tid >> 6), nw = gridDim.x * NWV;
    const int gt = blockIdx.x * NTHR + tid, nt = gridDim.x * NTHR;
    {
        bf16_t* xb = (bf16_t*)(ws + OFF_XB); float* rinv1 = (float*)(ws + OFF_RINV1);
        for (int t = gw; t < T; t += nw) {
            const f32x4* src = (const f32x4*)(P.x + (size_t)t * DM);
            f32x4 v[4]; float ss = 0.f;
#pragma unroll
            for (int i = 0; i < 4; ++i) { v[i] = src[lane + 64 * i]; ss += v[i][0] * v[i][0] + v[i][1] * v[i][1] + v[i][2] * v[i][2] + v[i][3] * v[i][3]; }
            ss = wave_sum(ss);
            if (lane == 0) rinv1[t] = rsqrtf(ss * (1.0f / DM) + RMS_EPS);
            u32x2* dst = (u32x2*)(xb + (size_t)t * XB_LD);
#pragma unroll
            for (int i = 0; i < 4; ++i) dst[lane + 64 * i] = (u32x2){pk_bf16(v[i][0], v[i][1]), pk_bf16(v[i][2], v[i][3])};
        }
    }
    {
        float* cosA = (float*)(ws + OFF_COSA); float* sinA = (float*)(ws + OFF_SINA);
        float* cosB = (float*)(ws + OFF_COSB); float* sinB = (float*)(ws + OFF_SINB);
        const int i = gt & 31;
        const float fa = powf(10000.0f, -(float)(2 * i) / 64.0f);
        const float fb = powf(10000.0f, -(float)(2 * (i & 15)) / 32.0f);
        for (int idx = gt; idx < T * 32; idx += nt) {
            const int t = idx >> 5;
            const float pos = (float)P.pos[t];
            float sa, ca; sincosf(pos * fa, &sa, &ca);
            cosA[idx] = ca; sinA[idx] = sa;
            if (i < 16) {
                float sb, cb; sincosf(pos * fb, &sb, &cb);
                cosB[t * 16 + i] = cb; sinB[t * 16 + i] = sb;
            }
        }
    }
    transpose_w(P.w_in, 4000, 1024, 4096, P.mix_g, (bf16_t*)(ws + OFF_WTIN),
                [](int n) { return n < 1920 ? n : (n < 3968 ? n + 32 : (n < 4000 ? n - 3968 + 1920 : -1)); }, gw, nw, lane);
    transpose_w(P.w_qup, 768, 256, 768, P.qn_g, (bf16_t*)(ws + OFF_WTQUP),
                [](int n) { return n < 512 ? (n >> 6) * 96 + (n & 63) : ((n - 512) >> 5) * 96 + 64 + ((n - 512) & 31); }, gw, nw, lane);
    transpose_w(P.w_kvup, 1024, 128, 1024, P.kvn_g, (bf16_t*)(ws + OFF_WTKVUP),
                [](int n) { return n < 512 ? (n >> 6) * 128 + (n & 63) : ((n - 512) >> 6) * 128 + 64 + ((n - 512) & 63); }, gw, nw, lane);
    transpose_w(P.w_a, 1024, 512, 1024, nullptr, (bf16_t*)(ws + OFF_WTA), [](int n) { return n; }, gw, nw, lane);
    transpose_w(P.w_b, 1024, 512, 1024, nullptr, (bf16_t*)(ws + OFF_WTB), [](int n) { return n; }, gw, nw, lane);
    transpose_w(P.w_out, 1024, 1024, 1024, nullptr, (bf16_t*)(ws + OFF_WTOUT), [](int n) { return n; }, gw, nw, lane);
    transpose_w(P.w_pq, 2048, 1024, 2048, P.ffn_g, (bf16_t*)(ws + OFF_WTPQ), [](int n) { return n; }, gw, nw, lane);
    {
        bf16_t* kb = (bf16_t*)(ws + OFF_KEYS);
        for (int idx = gt; idx < 2 * 131072 / 4; idx += nt) {
            const int e = idx * 4; const float* src = e < 131072 ? P.keys1 + e : P.keys2 + (e - 131072);
            const f32x4 v = *(const f32x4*)src;
            *(u32x2*)(kb + e) = (u32x2){pk_bf16(v[0], v[1]), pk_bf16(v[2], v[3])};
        }
    }
}

constexpr int LSTR = 72;
constexpr int GEMM_LDS = 2 * 256 * LSTR * 2;
#define LDS_BARRIER() do { asm volatile("s_waitcnt lgkmcnt(0)" ::: "memory"); __builtin_amdgcn_s_barrier(); asm volatile("" ::: "memory"); } while (0)
#define LAS3 __attribute__((address_space(3)))
constexpr int GSTAGE = 65536;
template <bool ZERO>
DI void gemm_main(const bf16_t* __restrict__ A, int lda, const bf16_t* __restrict__ Bt, int ldb, int K, char* smem, f32x4 (&acc)[8][4]) {
    const int tid = tid_fresh(), lane = tid & 63, wid = __builtin_amdgcn_readfirstlane(tid >> 6), wr = wid >> 2, wc = wid & 3;
    const char* Ab = (const char*)A; const char* Bb = (const char*)Bt;
    unsigned aoff[4], boff[4];
#pragma unroll
    for (int i = 0; i < 4; ++i) {
        const int row = 8 * (wid + 8 * i) + (lane >> 3), c = (lane & 7) ^ ((row >> 1) & 7);
        aoff[i] = (unsigned)(row * lda + c * 8) * 2u; boff[i] = (unsigned)(row * ldb + c * 8) * 2u;
    }
#define GM_DMA(buf, kk) do { const char* a_ = Ab + (size_t)(kk) * 2; const char* b_ = Bb + (size_t)(kk) * 2; \
        _Pragma("unroll") for (int i = 0; i < 4; ++i) __builtin_amdgcn_global_load_lds((const unsigned*)(a_ + aoff[i]), (LAS3 unsigned*)(smem + (buf) * GSTAGE + (wid + 8 * i) * 1024), 16, 0, 0); \
        _Pragma("unroll") for (int i = 0; i < 4; ++i) __builtin_amdgcn_global_load_lds((const unsigned*)(b_ + boff[i]), (LAS3 unsigned*)(smem + (buf) * GSTAGE + 32768 + (wid + 8 * i) * 1024), 16, 0, 0); } while (0)
    if (ZERO) {
#pragma unroll
        for (int m = 0; m < 8; ++m)
#pragma unroll
            for (int n = 0; n < 4; ++n) acc[m][n] = (f32x4){0.f, 0.f, 0.f, 0.f};
    }
    const int sw = (lane & 15) >> 1, q4 = lane >> 4;
    const int abase = (128 * wr + (lane & 15)) * 128, bbase = 32768 + (64 * wc + (lane & 15)) * 128;
    const int sl0 = ((q4) ^ sw) * 16, sl1 = ((4 + q4) ^ sw) * 16;
    LDS_BARRIER();
    GM_DMA(0, 0);
    asm volatile("s_waitcnt vmcnt(0)" ::: "memory");
    LDS_BARRIER();
#pragma unroll 1
    for (int k0 = 0; k0 < K; k0 += 64) {
        const int cur = (k0 >> 6) & 1;
        if (k0 + 64 < K) GM_DMA(cur ^ 1, k0 + 64);
        const char* Sb = smem + cur * GSTAGE;
        bf16x8 bf0[4], bf1[4], afA[4], afB[4];
#define LD_B(dst, sl) do { _Pragma("unroll") for (int n = 0; n < 4; ++n) dst[n] = *(const bf16x8*)(Sb + bbase + n * 2048 + (sl)); } while (0)
#define LD_A(dst, mh, sl) do { _Pragma("unroll") for (int m = 0; m < 4; ++m) dst[m] = *(const bf16x8*)(Sb + abase + (4 * (mh) + m) * 2048 + (sl)); } while (0)
#define MM(mh, af, bf) do { _Pragma("unroll") for (int m = 0; m < 4; ++m) _Pragma("unroll") for (int n = 0; n < 4; ++n) acc[4 * (mh) + m][n] = MFMA16(bf[n], af[m], acc[4 * (mh) + m][n]); } while (0)
        LD_B(bf0, sl0); LD_A(afA, 0, sl0);
        __builtin_amdgcn_sched_barrier(0);
        LD_A(afB, 1, sl0);
        __builtin_amdgcn_sched_barrier(0);
        MM(0, afA, bf0);
        __builtin_amdgcn_sched_barrier(0);
        LD_B(bf1, sl1); LD_A(afA, 0, sl1);
        __builtin_amdgcn_sched_barrier(0);
        MM(1, afB, bf0);
        __builtin_amdgcn_sched_barrier(0);
        LD_A(afB, 1, sl1);
        __builtin_amdgcn_sched_barrier(0);
        MM(0, afA, bf1);
        __builtin_amdgcn_sched_barrier(0);
        MM(1, afB, bf1);
        __builtin_amdgcn_sched_barrier(0);
#undef LD_B
#undef LD_A
#undef MM
        asm volatile("s_waitcnt vmcnt(0)" ::: "memory");
        LDS_BARRIER();
    }
#undef GM_DMA
}

struct BlkMap { int xcd, rank, cnt, ok; };
DI unsigned xcc_id() { return (unsigned)__builtin_amdgcn_s_getreg((3 << 11) | 20) & 0xFu; }
DI int tile_count(const BlkMap& bm, int Mt, int Nt) { return bm.ok ? (Mt * Nt) >> 3 : Mt * Nt; }
DI int tile_first(const BlkMap& bm) { return bm.ok ? bm.rank : (int)blockIdx.x; }
DI int tile_step(const BlkMap& bm) { return bm.ok ? bm.cnt : (int)gridDim.x; }
DI void tile_map(const BlkMap& bm, int j, int Mt, int Nt, int& mt, int& nt) {
    if (bm.ok) {
        const int slot = j & 31, sid = (j >> 5) * 8 + bm.xcd, snn = Nt >> 2;
        const int sm = sid / snn, sn = sid % snn;
        mt = 8 * sm + (slot >> 2); nt = 4 * sn + (slot & 3);
    } else { mt = j / Nt; nt = j % Nt; }
}

constexpr int WST = 144;
constexpr int WST_BYTES = 128 * WST;
DI void stg_put(char* wl, int lrow, int lcol, const f32x4& v) { *(u32x2*)(wl + lrow * WST + lcol * 2) = (u32x2){pk_bf16(v[0], v[1]), pk_bf16(v[2], v[3])}; }
DI void stg_flush(char* wl, bf16_t* dst, size_t ld, int lane, int ncols = 64) {
    asm volatile("" : "+v"(lane) :: "memory");
    const int rr = lane >> 3, ch = lane & 7;
#pragma unroll 4
    for (int j = 0; j < 16; ++j) {
        const int row = 8 * j + rr;
        const u32x4 w = *(const u32x4*)(wl + row * WST + ch * 16);
        if (ch * 8 < ncols) *(u32x4*)(dst + (size_t)row * ld + ch * 8) = w;
    }
    asm volatile("" ::: "memory");
}
DI void st4(bf16_t* dst, const f32x4& v) { *(u32x2*)dst = (u32x2){pk_bf16(v[0], v[1]), pk_bf16(v[2], v[3])}; }

DI void phase_inproj(const Params& P, char* smem, const BlkMap& bm) {
    char* ws = P.ws;
    const bf16_t* xb = (const bf16_t*)(ws + OFF_XB); const bf16_t* wt = (const bf16_t*)(ws + OFF_WTIN);
    const float* rinv1 = (const float*)(ws + OFF_RINV1);
    const float* cosA = (const float*)(ws + OFF_COSA); const float* sinA = (const float*)(ws + OFF_SINA);
    const float* cosB = (const float*)(ws + OFF_COSB); const float* sinB = (const float*)(ws + OFF_SINB);
    bf16_t* qa = (bf16_t*)(ws + OFF_QA); bf16_t* ka = (bf16_t*)(ws + OFF_KA); bf16_t* vaT = (bf16_t*)(ws + OFF_VAT);
    bf16_t* cq = (bf16_t*)(ws + OFF_CQ); bf16_t* ckv = (bf16_t*)(ws + OFF_CKV); bf16_t* kpe = (bf16_t*)(ws + OFF_KPE);
    bf16_t* ga = (bf16_t*)(ws + OFF_GA); bf16_t* gb = (bf16_t*)(ws + OFF_GB);
    const int tid = tid_fresh(), lane = tid & 63, wid = __builtin_amdgcn_readfirstlane(tid >> 6), wr = wid >> 2, wc = wid & 3, q4 = lane >> 4;
    constexpr int Mt = T / 256, Nt = 16;
    for (int v = tile_first(bm); v < tile_count(bm, Mt, Nt); v += tile_step(bm)) {
        int mt, nt; tile_map(bm, v, Mt, Nt, mt, nt);
        const int row0 = mt * 256, col0 = nt * 256;
        f32x4 acc[8][4];
        gemm_main<true>(xb + (size_t)row0 * XB_LD, XB_LD, wt + (size_t)col0 * DM, DM, DM, smem, acc);
        const int cb = col0 + 64 * wc;
        char* wl = smem + wid * WST_BYTES;
        const size_t tw0 = (size_t)row0 + 128 * wr;
        const int lr0 = lane & 15;
        if (cb < 1024) {
            const bool isq = cb < 512;
#pragma unroll
            for (int m = 0; m < 8; ++m) {
                const size_t t = tw0 + 16 * m + lr0;
                const float sc = isq ? rinv1[t] * QS_A : rinv1[t];
#pragma unroll
                for (int n = 0; n < 2; ++n) {
                    const f32x4 c = *(const f32x4*)(cosA + t * 32 + 16 * n + 4 * q4), s = *(const f32x4*)(sinA + t * 32 + 16 * n + 4 * q4);
                    const f32x4 x1 = acc[m][n] * sc, x2 = acc[m][n + 2] * sc;
                    stg_put(wl, 16 * m + lr0, 16 * n + 4 * q4, x1 * c - x2 * s);
                    stg_put(wl, 16 * m + lr0, 32 + 16 * n + 4 * q4, x2 * c + x1 * s);
                }
                asm volatile("" ::: "memory");
            }
            stg_flush(wl, (isq ? qa : ka) + tw0 * 512 + (cb & 511), 512, lane);
        } else if (cb < 1536) {
            const int h = (cb - 1024) >> 6;
#pragma unroll
            for (int m = 0; m < 8; ++m) {
                const int t = (int)tw0 + 16 * m + lr0;
                const float r = rinv1[t];
                const int b = t >> 12, s = t & 4095;
                bf16_t* dst = vaT + ((size_t)(b * 8 + h) * 64 + 4 * q4) * SEQ + s;
#pragma unroll
                for (int n = 0; n < 4; ++n)
#pragma unroll
                    for (int i = 0; i < 4; ++i) dst[(size_t)(16 * n + i) * SEQ] = f2bf(acc[m][n][i] * r);
            }
        } else if (cb < 1920) {
#pragma unroll
            for (int m = 0; m < 8; ++m) {
                const float r = rinv1[tw0 + 16 * m + lr0];
#pragma unroll
                for (int n = 0; n < 4; ++n) stg_put(wl, 16 * m + lr0, 16 * n + 4 * q4, acc[m][n] * r);
                asm volatile("" ::: "memory");
            }
            if (cb < 1792) stg_flush(wl, cq + tw0 * 256 + (cb - 1536), 256, lane);
            else stg_flush(wl, ckv + tw0 * 128 + (cb - 1792), 128, lane);
        } else if (cb < 3968) {
#pragma unroll
            for (int m = 0; m < 8; ++m) {
                const float r = rinv1[tw0 + 16 * m + lr0];
#pragma unroll
                for (int n = 0; n < 4; ++n) {
                    f32x4 z = acc[m][n] * r, o;
#pragma unroll
                    for (int i = 0; i < 4; ++i) o[i] = __builtin_amdgcn_rcpf(1.0f + __expf(-z[i]));
                    stg_put(wl, 16 * m + lr0, 16 * n + 4 * q4, o);
                }
                asm volatile("" ::: "memory");
            }
            stg_flush(wl, (cb < 2944 ? ga + tw0 * 1024 + (cb - 1920) : gb + tw0 * 1024 + (cb - 2944)), 1024, lane);
        } else if (cb == 3968) {
#pragma unroll
            for (int m = 0; m < 8; ++m) {
                const size_t t = tw0 + 16 * m + lr0;
                const float r = rinv1[t];
                const f32x4 c = *(const f32x4*)(cosB + t * 16 + 4 * q4), s = *(const f32x4*)(sinB + t * 16 + 4 * q4);
                const f32x4 x1 = acc[m][0] * r, x2 = acc[m][1] * r;
                stg_put(wl, 16 * m + lr0, 4 * q4, x1 * c - x2 * s);
                stg_put(wl, 16 * m + lr0, 16 + 4 * q4, x2 * c + x1 * s);
                asm volatile("" ::: "memory");
            }
            stg_flush(wl, kpe + tw0 * 32, 32, lane, 32);
        }
    }
}

DI void row_rinv256(const bf16_t* __restrict__ A, int lda, int K, float* s_rinv) {
    const int tid = tid_fresh(), row = tid >> 1, hf = tid & 1;
    const u32x4* p = (const u32x4*)(A + (size_t)row * lda + hf * (K / 2));
    float ss = 0.f;
    for (int c = 0; c < K / 16; ++c) {
        const u32x4 w = p[c];
#pragma unroll
        for (int j = 0; j < 4; ++j) { const float a = bf_lo(w[j]), b = bf_hi(w[j]); ss += a * a + b * b; }
    }
    ss += __shfl_xor(ss, 1);
    if (!hf) s_rinv[row] = rsqrtf(ss / (float)K + RMS_EPS);
}

DI void phase_mla_up(const Params& P, char* smem) {
    char* ws = P.ws;
    const bf16_t* cq = (const bf16_t*)(ws + OFF_CQ); const bf16_t* ckv = (const bf16_t*)(ws + OFF_CKV);
    const bf16_t* wq = (const bf16_t*)(ws + OFF_WTQUP); const bf16_t* wkv = (const bf16_t*)(ws + OFF_WTKVUP);
    const float* cosB = (const float*)(ws + OFF_COSB); const float* sinB = (const float*)(ws + OFF_SINB);
    bf16_t* qn = (bf16_t*)(ws + OFF_QN); bf16_t* qpe = (bf16_t*)(ws + OFF_QPE); bf16_t* kn = (bf16_t*)(ws + OFF_KN); bf16_t* vbT = (bf16_t*)(ws + OFF_VBT);
    const bf16_t* ka = (const bf16_t*)(ws + OFF_KA); float* kmean = (float*)(ws + OFF_KMEAN);
    float* s_rinv = (float*)(smem + 2 * GEMM_LDS);
    char* wl = smem + (threadIdx.x >> 6) * WST_BYTES;
    const int tid = tid_fresh(), lane = tid & 63, wid = __builtin_amdgcn_readfirstlane(tid >> 6), wr = wid >> 2, wc = wid & 3, q4 = lane >> 4;
    constexpr int Mt = T / 256;
    constexpr int N_Q = Mt * 3, N_KV = Mt * 4, N_KM = 128;
    for (int v = blockIdx.x; v < N_Q; v += gridDim.x) {
        __syncthreads();
        {
            const int mt = v / 3, nt = v % 3, row0 = mt * 256, col0 = nt * 256;
            row_rinv256(cq + (size_t)row0 * 256, 256, 256, s_rinv);
            f32x4 acc[8][4];
            gemm_main<true>(cq + (size_t)row0 * 256, 256, wq + (size_t)col0 * 256, 256, 256, smem, acc);
            const int cb = col0 + 64 * wc;
#pragma unroll
            for (int m = 0; m < 8; ++m) {
                const int lr = 128 * wr + 16 * m + (lane & 15), t = row0 + lr;
                const float r = s_rinv[lr] * QS_B;
                if (cb < 512) {
#pragma unroll
                    for (int n = 0; n < 4; ++n) stg_put(wl, lr - 128 * wr, 16 * n + 4 * q4, acc[m][n] * r);
                } else {
                    const f32x4 c = *(const f32x4*)(cosB + (size_t)t * 16 + 4 * q4), s = *(const f32x4*)(sinB + (size_t)t * 16 + 4 * q4);
#pragma unroll
                    for (int pr = 0; pr < 2; ++pr) {
                        const f32x4 x1 = acc[m][2 * pr] * r, x2 = acc[m][2 * pr + 1] * r;
                        stg_put(wl, lr - 128 * wr, 32 * pr + 4 * q4, x1 * c - x2 * s);
                        stg_put(wl, lr - 128 * wr, 32 * pr + 16 + 4 * q4, x2 * c + x1 * s);
                    }
                }
            }
            if (cb < 512) stg_flush(wl, qn + ((size_t)row0 + 128 * wr) * 512 + cb, 512, lane);
            else stg_flush(wl, qpe + ((size_t)row0 + 128 * wr) * 256 + (cb - 512), 256, lane);
        }
    }
    for (int v = N_Q + blockIdx.x; v < N_Q + N_KV; v += gridDim.x) {
        __syncthreads();
        {
            const int u = v - N_Q, mt = u >> 2, nt = u & 3, row0 = mt * 256, col0 = nt * 256;
            row_rinv256(ckv + (size_t)row0 * 128, 128, 128, s_rinv);
            f32x4 acc[8][4];
            gemm_main<true>(ckv + (size_t)row0 * 128, 128, wkv + (size_t)col0 * 128, 128, 128, smem, acc);
            const int cb = col0 + 64 * wc;
#pragma unroll
            for (int m = 0; m < 8; ++m) {
                const int lr = 128 * wr + 16 * m + (lane & 15), t = row0 + lr;
                const float r = s_rinv[lr];
                if (cb < 512) {
#pragma unroll
                    for (int n = 0; n < 4; ++n) stg_put(wl, lr - 128 * wr, 16 * n + 4 * q4, acc[m][n] * r);
                } else {
                    const int h = (cb - 512) >> 6, b = t >> 12, s = t & 4095;
                    bf16_t* dst = vbT + ((size_t)(b * 8 + h) * 64 + 4 * q4) * SEQ + s;
#pragma unroll
                    for (int n = 0; n < 4; ++n)
#pragma unroll
                        for (int i = 0; i < 4; ++i) dst[(size_t)(16 * n + i) * SEQ] = f2bf(acc[m][n][i] * r);
                }
            }
            if (cb < 512) stg_flush(wl, kn + ((size_t)row0 + 128 * wr) * 512 + cb, 512, lane);
        }
    }
    for (int v = N_Q + N_KV + (int)((blockIdx.x + (gridDim.x >> 1)) % gridDim.x); v < N_Q + N_KV + N_KM; v += gridDim.x) {
        {
            const int u = v - N_Q - N_KV, b = u >> 4, blk = u & 15;
            if (tid < 256) {
                const unsigned* src = (const unsigned*)(ka + ((size_t)b * SEQ + blk * 256) * 512) + tid;
                float s0 = 0.f, s1 = 0.f;
                for (int rr = 0; rr < 256; ++rr) { const unsigned w = src[(size_t)rr * 256]; s0 += bf_lo(w); s1 += bf_hi(w); }
                const int c = 2 * tid, h = c >> 6, d = c & 63;
                float* dst = kmean + ((size_t)((b * 8 + h) * 16 + blk)) * 64 + d;
                dst[0] = s0 * (1.0f / 256.0f); dst[1] = s1 * (1.0f / 256.0f);
            }
        }
    }
}

constexpr int NSUB = 4, KVT = 32 * NSUB;
constexpr int VSTR = KVT + 4;
constexpr int ATT_V_OFF = 2 * KVT * 104 * 2;
constexpr int ATT_ITEM_OFF = ATT_V_OFF + 2 * 64 * VSTR * 2;
template <bool MOBA>
DI void attn_item(const Params& P, int bh, int qt, char* smem) {
    constexpr int DK = MOBA ? 64 : 96, KS = DK / 16, KSTR = DK + 8;
    char* ws = P.ws;
    bf16_t* Ks = (bf16_t*)smem; bf16_t* Vs = (bf16_t*)(smem + ATT_V_OFF);
    const int tid = tid_fresh(), lane = tid & 63, w = __builtin_amdgcn_readfirstlane(tid >> 6), ql = lane & 31, hh = lane >> 5;
    const int b = bh >> 3, h = bh & 7, s0 = qt * 256, sq = s0 + 32 * w + ql;
    const size_t tq = (size_t)b * SEQ + sq;
    const bf16_t* Kg = (const bf16_t*)(ws + (MOBA ? OFF_KA : OFF_KN));
    const bf16_t* kpe = (const bf16_t*)(ws + OFF_KPE);
    const bf16_t* vT = (const bf16_t*)(ws + (MOBA ? OFF_VAT : OFF_VBT)) + (size_t)bh * 64 * SEQ;
    bf16x8 qf[KS];
    if (MOBA) {
        const bf16_t* qa = (const bf16_t*)(ws + OFF_QA) + tq * 512 + h * 64 + 8 * hh;
#pragma unroll
        for (int ks = 0; ks < 4; ++ks) qf[ks] = *(const bf16x8*)(qa + 16 * ks);
    } else {
        const bf16_t* qn = (const bf16_t*)(ws + OFF_QN) + tq * 512 + h * 64 + 8 * hh;
        const bf16_t* qp = (const bf16_t*)(ws + OFF_QPE) + tq * 256 + h * 32 + 8 * hh;
#pragma unroll
        for (int ks = 0; ks < 4; ++ks) qf[ks] = *(const bf16x8*)(qn + 16 * ks);
#pragma unroll
        for (int ks = 4; ks < KS; ++ks) qf[ks] = *(const bf16x8*)(qp + 16 * (ks - 4));
    }
    unsigned selmask = 0xffffffffu;
    if (MOBA) {
        const int blk = qt;
        float qv[32];
#pragma unroll
        for (int ks = 0; ks < 4; ++ks) {
            const u32x4 wq = __builtin_bit_cast(u32x4, qf[ks]);
#pragma unroll
            for (int j = 0; j < 4; ++j) { qv[8 * ks + 2 * j] = bf_lo(wq[j]); qv[8 * ks + 2 * j + 1] = bf_hi(wq[j]); }
        }
        const float* km = (const float*)(ws + OFF_KMEAN) + (size_t)bh * 16 * 64 + 8 * hh;
        float g[16];
#pragma unroll
        for (int n = 0; n < 16; ++n) {
            float a = -INFINITY;
            if (n < blk) {
                a = 0.f;
#pragma unroll
                for (int ks = 0; ks < 4; ++ks) {
                    const f32x4 k0 = *(const f32x4*)(km + n * 64 + 16 * ks), k1 = *(const f32x4*)(km + n * 64 + 16 * ks + 4);
#pragma unroll
                    for (int j = 0; j < 4; ++j) { a += qv[8 * ks + j] * k0[j]; a += qv[8 * ks + 4 + j] * k1[j]; }
                }
                a += __shfl_xor(a, 32);
            }
            g[n] = a;
        }
        unsigned mask = 0u;
        if (blk <= 3) mask = (1u << blk) - 1u;
        else {
#pragma unroll
            for (int r = 0; r < 3; ++r) {
                float best = -INFINITY; int bi = 0;
#pragma unroll
                for (int n = 0; n < 16; ++n) if (g[n] > best) { best = g[n]; bi = n; }
                mask |= 1u << bi;
#pragma unroll
                for (int n = 0; n < 16; ++n) g[n] = (n == bi) ? -INFINITY : g[n];
            }
        }
        selmask = mask | (1u << blk);
    }
    const int krow = tid >> 3, kch = tid & 7;
    const int vd = tid >> 4, vch = tid & 15;
    const bf16_t* kp0 = Kg + ((size_t)b * SEQ + krow) * 512 + h * 64 + kch * 8;
    const bf16_t* kpp = kpe + ((size_t)b * SEQ + (tid >> 2)) * 32 + (tid & 3) * 8;
    const bf16_t* vp0 = vT + (size_t)vd * SEQ + vch * 8;
    u32x4 rk[3], rv[2];
    const int nkt = 2 * qt + 2;
#define ATT_GLOAD(kt) do { \
        rk[0] = *(const u32x4*)(kp0 + (size_t)(KVT * (kt)) * 512); rk[1] = *(const u32x4*)(kp0 + (size_t)(KVT * (kt) + 64) * 512); \
        if (!MOBA) rk[2] = *(const u32x4*)(kpp + (size_t)(KVT * (kt)) * 32); \
        rv[0] = *(const u32x4*)(vp0 + KVT * (kt)); rv[1] = *(const u32x4*)(vp0 + (size_t)32 * SEQ + KVT * (kt)); } while (0)
    ATT_GLOAD(0);
    f32x16 O[2];
#pragma unroll
    for (int i = 0; i < 16; ++i) { O[0][i] = 0.f; O[1][i] = 0.f; }
    float mrun = -INFINITY, lrun = 0.f;
    const int wq0 = s0 + 32 * w;
    for (int kt = 0; kt < nkt; ++kt) {
        bf16_t* Kb = Ks + (kt & 1) * KVT * KSTR; bf16_t* Vb = Vs + (kt & 1) * 64 * VSTR;
        *(u32x4*)(Kb + krow * KSTR + kch * 8) = rk[0];
        *(u32x4*)(Kb + (krow + 64) * KSTR + kch * 8) = rk[1];
        if (!MOBA) *(u32x4*)(Kb + (tid >> 2) * KSTR + 64 + (tid & 3) * 8) = rk[2];
        *(u32x2*)(Vb + vd * VSTR + vch * 8) = (u32x2){rv[0][0], rv[0][1]};
        *(u32x2*)(Vb + vd * VSTR + vch * 8 + 4) = (u32x2){rv[0][2], rv[0][3]};
        *(u32x2*)(Vb + (vd + 32) * VSTR + vch * 8) = (u32x2){rv[1][0], rv[1][1]};
        *(u32x2*)(Vb + (vd + 32) * VSTR + vch * 8 + 4) = (u32x2){rv[1][2], rv[1][3]};
        __syncthreads();
        if (kt + 1 < nkt) ATT_GLOAD(kt + 1);
        const int kbase = KVT * kt;
        if (kbase <= wq0 + 31) {
            f32x16 Sv[NSUB];
#pragma unroll
            for (int sub = 0; sub < NSUB; ++sub) {
#pragma unroll
                for (int i = 0; i < 16; ++i) Sv[sub][i] = 0.f;
#pragma unroll
                for (int ks = 0; ks < KS; ++ks) {
                    const bf16x8 kf = *(const bf16x8*)(Kb + (32 * sub + ql) * KSTR + 16 * ks + 8 * hh);
                    Sv[sub] = MFMA32(kf, qf[ks], Sv[sub]);
                }
            }
            if (kbase + KVT - 1 > wq0) {
#pragma unroll
                for (int sub = 0; sub < NSUB; ++sub) {
                    const int thr = sq - kbase - 32 * sub - 4 * hh;
#pragma unroll
                    for (int i = 0; i < 16; ++i) if (((i & 3) + 8 * (i >> 2)) > thr) Sv[sub][i] = -INFINITY;
                }
            }
            float mt = -INFINITY;
#pragma unroll
            for (int i = 0; i < 16; ++i) mt = fmaxf(fmaxf(mt, fmaxf(Sv[0][i], Sv[1][i])), fmaxf(Sv[2][i], Sv[3][i]));
            mt = fmaxf(mt, __shfl_xor(mt, 32));
            bool sel = true;
            if (MOBA) { sel = (selmask >> (kbase >> 8)) & 1u; if (!sel) mt = -INFINITY; }
            const bool need = mt > mrun + 8.0f;
            if (__builtin_amdgcn_ballot_w64(need) != 0ull) {
                const float mnew = fmaxf(mrun, mt);
                const float ms = (mnew == -INFINITY) ? 0.f : mnew;
                const float alpha = __builtin_amdgcn_exp2f(mrun - ms);
                lrun *= alpha; mrun = mnew;
#pragma unroll
                for (int i = 0; i < 16; ++i) { O[0][i] *= alpha; O[1][i] *= alpha; }
            }
            const float msafe = (mrun == -INFINITY) ? 0.f : mrun;
            const float msub = sel ? msafe : INFINITY;
            float psum = 0.f;
#pragma unroll
            for (int sub = 0; sub < NSUB; ++sub)
#pragma unroll
                for (int i = 0; i < 16; ++i) { const float pv = __builtin_amdgcn_exp2f(Sv[sub][i] - msub); Sv[sub][i] = pv; psum += pv; }
            lrun += psum;
#pragma unroll
            for (int sub = 0; sub < NSUB; ++sub)
#pragma unroll
                for (int s = 0; s < 2; ++s) {
                    u32x4 pw;
#pragma unroll
                    for (int j = 0; j < 4; ++j) pw[j] = pk_bf16(Sv[sub][8 * s + 2 * j], Sv[sub][8 * s + 2 * j + 1]);
                    const bf16x8 pf = __builtin_bit_cast(bf16x8, pw);
#pragma unroll
                    for (int dt = 0; dt < 2; ++dt) {
                        const bf16_t* vrow = Vb + (32 * dt + ql) * VSTR + 32 * sub + 16 * s + 4 * hh;
                        const u32x2 v0 = *(const u32x2*)vrow, v1 = *(const u32x2*)(vrow + 8);
                        const bf16x8 vf = __builtin_bit_cast(bf16x8, (u32x4){v0[0], v0[1], v1[0], v1[1]});
                        O[dt] = MFMA32(vf, pf, O[dt]);
                    }
                }
        }
    }
#undef ATT_GLOAD
    lrun += __shfl_xor(lrun, 32);
    const float inv = 1.0f / lrun;
    bf16_t* y = (bf16_t*)(ws + (MOBA ? OFF_YA : OFF_YB)) + tq * 512 + h * 64 + 4 * hh;
#pragma unroll
    for (int dt = 0; dt < 2; ++dt)
#pragma unroll
        for (int g = 0; g < 4; ++g)
            *(u32x2*)(y + 32 * dt + 8 * g) = (u32x2){pk_bf16(O[dt][4 * g] * inv, O[dt][4 * g + 1] * inv), pk_bf16(O[dt][4 * g + 2] * inv, O[dt][4 * g + 3] * inv)};
}

DI void phase_attn(const Params& P, char* smem, int ci = 0) {
    unsigned* ctr = (unsigned*)(P.ws + OFF_CTR) + ci;
    int* s_item = (int*)(smem + ATT_ITEM_OFF);
    for (;;) {
        __syncthreads();
        if (threadIdx.x == 0) *s_item = (int)atomicAdd(ctr, 1u);
        __syncthreads();
        const int item = *s_item;
        if (item >= 2048) break;
        const int qt = 15 - (item >> 7), rest = item & 127, bh = rest & 63;
        if (rest < 64) attn_item<false>(P, bh, qt, smem); else attn_item<true>(P, bh, qt, smem);
    }
}

DI void phase_merge(const Params& P, char* smem, const BlkMap& bm) {
    char* ws = P.ws;
    const bf16_t* ya = (const bf16_t*)(ws + OFF_YA); const bf16_t* yb = (const bf16_t*)(ws + OFF_YB);
    const bf16_t* wa = (const bf16_t*)(ws + OFF_WTA); const bf16_t* wb = (const bf16_t*)(ws + OFF_WTB);
    const bf16_t* ga = (const bf16_t*)(ws + OFF_GA); const bf16_t* gb = (const bf16_t*)(ws + OFF_GB);
    bf16_t* merged = (bf16_t*)(ws + OFF_MERGED);
    const int tid = tid_fresh(), lane = tid & 63, wid = __builtin_amdgcn_readfirstlane(tid >> 6), wr = wid >> 2, wc = wid & 3, q4 = lane >> 4;
    char* wl = smem + wid * WST_BYTES;
    constexpr int Mt = T / 256, Nt = 4;
    for (int v = tile_first(bm); v < tile_count(bm, Mt, Nt); v += tile_step(bm)) {
        int mt, nt; tile_map(bm, v, Mt, Nt, mt, nt);
        const int row0 = mt * 256, col0 = nt * 256;
        f32x4 acc[8][4];
        gemm_main<true>(ya + (size_t)row0 * 512, 512, wa + (size_t)col0 * 512, 512, 512, smem, acc);
#pragma unroll
        for (int m = 0; m < 8; ++m) {
            const size_t t = row0 + 128 * wr + 16 * m + (lane & 15);
#pragma unroll
            for (int n = 0; n < 4; ++n) {
                const int c = col0 + 64 * wc + 16 * n + 4 * q4;
                const u32x2 wa2 = *(const u32x2*)(ga + t * 1024 + c), wb2 = *(const u32x2*)(gb + t * 1024 + c);
                acc[m][n][0] *= bf_lo(wa2[0]) / fmaxf(bf_lo(wb2[0]), 1e-30f);
                acc[m][n][1] *= bf_hi(wa2[0]) / fmaxf(bf_hi(wb2[0]), 1e-30f);
                acc[m][n][2] *= bf_lo(wa2[1]) / fmaxf(bf_lo(wb2[1]), 1e-30f);
                acc[m][n][3] *= bf_hi(wa2[1]) / fmaxf(bf_hi(wb2[1]), 1e-30f);
            }
        }
        gemm_main<false>(yb + (size_t)row0 * 512, 512, wb + (size_t)col0 * 512, 512, 512, smem, acc);
#pragma unroll
        for (int m = 0; m < 8; ++m) {
            const size_t t = row0 + 128 * wr + 16 * m + (lane & 15);
#pragma unroll
            for (int n = 0; n < 4; ++n) {
                const int c = col0 + 64 * wc + 16 * n + 4 * q4;
                const u32x2 wb2 = *(const u32x2*)(gb + t * 1024 + c);
                f32x4 o;
                o[0] = fmaxf(bf_lo(wb2[0]), 1e-30f) * acc[m][n][0]; o[1] = fmaxf(bf_hi(wb2[0]), 1e-30f) * acc[m][n][1];
                o[2] = fmaxf(bf_lo(wb2[1]), 1e-30f) * acc[m][n][2]; o[3] = fmaxf(bf_hi(wb2[1]), 1e-30f) * acc[m][n][3];
                stg_put(wl, 16 * m + (lane & 15), 16 * n + 4 * q4, o);
            }
        }
        stg_flush(wl, merged + ((size_t)row0 + 128 * wr) * 1024 + col0 + 64 * wc, 1024, lane);
    }
}

DI void phase_outproj(const Params& P, char* smem, const BlkMap& bm) {
    char* ws = P.ws;
    const bf16_t* merged = (const bf16_t*)(ws + OFF_MERGED); const bf16_t* wo = (const bf16_t*)(ws + OFF_WTOUT);
    float* x2 = (float*)(ws + OFF_X2); bf16_t* x2b = (bf16_t*)(ws + OFF_X2B); float* ssq2 = (float*)(ws + OFF_SSQ2);
    const int tid = tid_fresh(), lane = tid & 63, wid = __builtin_amdgcn_readfirstlane(tid >> 6), wr = wid >> 2, wc = wid & 3, q4 = lane >> 4;
    char* wl = smem + wid * WST_BYTES;
    constexpr int Mt = T / 256, Nt = 4;
    for (int v = tile_first(bm); v < tile_count(bm, Mt, Nt); v += tile_step(bm)) {
        int mt, nt; tile_map(bm, v, Mt, Nt, mt, nt);
        const int row0 = mt * 256, col0 = nt * 256;
        f32x4 acc[8][4];
        gemm_main<true>(merged + (size_t)row0 * 1024, 1024, wo + (size_t)col0 * 1024, 1024, 1024, smem, acc);
#pragma unroll
        for (int m = 0; m < 8; ++m) {
            const size_t t = row0 + 128 * wr + 16 * m + (lane & 15);
            float ssp = 0.f;
#pragma unroll
            for (int n = 0; n < 4; ++n) {
                const int c = col0 + 64 * wc + 16 * n + 4 * q4;
                const f32x4 o = *(const f32x4*)(P.x + t * 1024 + c) + acc[m][n];
                *(f32x4*)(x2 + t * 1024 + c) = o;
                stg_put(wl, 16 * m + (lane & 15), 16 * n + 4 * q4, o);
                ssp += o[0] * o[0] + o[1] * o[1] + o[2] * o[2] + o[3] * o[3];
            }
            ssp += __shfl_xor(ssp, 16); ssp += __shfl_xor(ssp, 32);
            if (q4 == 0) atomicAdd(ssq2 + t, ssp);
        }
        stg_flush(wl, x2b + ((size_t)row0 + 128 * wr) * 1024 + col0 + 64 * wc, 1024, lane);
    }
}

DI int mono(int b) { return b ^ ((b >> 31) & 0x7fffffff); }
DI void ins16(int (&a)[16], int v) {
#pragma unroll
    for (int s = 0; s < 16; ++s) { const int t = max(a[s], v); v = min(a[s], v); a[s] = t; }
}
DI void cex(int& hi, int& lo) { const int a = max(hi, lo), b = min(hi, lo); hi = a; lo = b; }
DI void bitonic_merge16(int (&a)[16]) {
#pragma unroll
    for (int j = 8; j > 0; j >>= 1)
#pragma unroll
        for (int i = 0; i < 16; ++i) { const int l = i ^ j; if (l > i) cex(a[i], a[l]); }
}
DI void bitonic_sort16(int (&a)[16]) {
#pragma unroll
    for (int k = 2; k <= 16; k <<= 1)
#pragma unroll
        for (int j = k >> 1; j > 0; j >>= 1)
#pragma unroll
            for (int i = 0; i < 16; ++i) { const int l = i ^ j; if (l > i) { if ((i & k) == 0) cex(a[i], a[l]); else cex(a[l], a[i]); } }
}
DI void merge_top16(int (&x)[16], const int (&y)[16]) {
#pragma unroll
    for (int i = 0; i < 16; ++i) x[i] = max(x[i], y[15 - i]);
    bitonic_merge16(x);
}
DI float rinv2_of(const float* ssq2, size_t t) { return rsqrtf(ssq2[t] * (1.0f / DM) + RMS_EPS); }
DI void peer_topk_task(const Params& P, const bf16_t* qrow, size_t t, int h, unsigned* lw, int ql, int hh) {
    char* ws = P.ws;
    const bf16_t* keysb = (const bf16_t*)(ws + OFF_KEYS);
    int* pidx = (int*)(ws + OFF_PIDX); float* pg = (float*)(ws + OFF_PG);
    int a[2][16];
#pragma unroll
    for (int half = 0; half < 2; ++half) {
        bf16x8 qf[8];
#pragma unroll
        for (int ks = 0; ks < 8; ++ks) qf[ks] = *(const bf16x8*)(qrow + half * 128 + 16 * ks + 8 * hh);
        const bf16_t* kb = keysb + (size_t)((half * 8 + h) * 128) * 128 + 8 * hh;
#pragma unroll
        for (int nt = 0; nt < 4; ++nt) {
            f32x16 acc;
#pragma unroll
            for (int i = 0; i < 16; ++i) acc[i] = 0.f;
#pragma unroll
            for (int ks = 0; ks < 8; ++ks) {
                const bf16x8 kf = *(const bf16x8*)(kb + (size_t)(32 * nt + ql) * 128 + 16 * ks);
                acc = MFMA32(kf, qf[ks], acc);
            }
            int kk[16];
#pragma unroll
            for (int i = 0; i < 16; ++i) {
                const int n = 32 * nt + (i & 3) + 8 * (i >> 2) + 4 * hh;
                kk[i] = (mono(__float_as_int(acc[i])) & ~127) | (127 - n);
            }
            bitonic_sort16(kk);
            if (nt == 0) {
#pragma unroll
                for (int s = 0; s < 16; ++s) a[half][s] = kk[s];
            } else merge_top16(a[half], kk);
        }
        int pa[16];
#pragma unroll
        for (int s = 0; s < 16; ++s) pa[s] = __shfl_xor(a[half][s], 32);
        merge_top16(a[half], pa);
    }
    float f1[16], f2[16];
#pragma unroll
    for (int i = 0; i < 16; ++i) { f1[i] = __int_as_float(mono(a[0][i] & ~127)); f2[i] = __int_as_float(mono(a[1][i] & ~127)); }
#pragma unroll
    for (int k = 0; k < 4; ++k) {
        unsigned w1 = 0u, w2 = 0u;
#pragma unroll
        for (int j = 0; j < 4; ++j) { w1 |= (unsigned)(127 - (a[0][4 * k + j] & 127)) << (8 * j); w2 |= (unsigned)(127 - (a[1][4 * k + j] & 127)) << (8 * j); }
        lw[k] = w1; lw[4 + k] = w2;
    }
    int bb[16];
#pragma unroll
    for (int s = 0; s < 16; ++s) bb[s] = (int)0x80000000;
#pragma unroll
    for (int i = 0; i < 16; ++i)
#pragma unroll
        for (int j = 0; j < 16; ++j)
            if ((i + 1) * (j + 1) <= 16) {
                const float c = f1[i] + f2[j];
                const int key = (mono(__float_as_int(c)) & ~255) | (i << 4) | j;
                ins16(bb, key);
            }
    const float r2 = rinv2_of((const float*)(ws + OFF_SSQ2), t);
    float z[16], e[16], sum = 0.f;
#pragma unroll
    for (int r = 0; r < 16; ++r) z[r] = __int_as_float(mono(bb[r] & ~255)) * r2;
#pragma unroll
    for (int r = 0; r < 16; ++r) { e[r] = __expf(z[r] - z[0]); sum += e[r]; }
    const float inv = 1.0f / sum;
    if (hh == 0) {
        int id[16];
#pragma unroll
        for (int r = 0; r < 16; ++r) {
            const int cid = bb[r] & 255, i = cid >> 4, j = cid & 15;
            const unsigned w1 = lw[i >> 2], w2 = lw[4 + (j >> 2)];
            const int n1 = (w1 >> (8 * (i & 3))) & 255, n2 = (w2 >> (8 * (j & 3))) & 255;
            id[r] = n1 * 128 + n2;
        }
        int* di = pidx + t * 128 + h * 16; float* dg = pg + t * 128 + h * 16;
#pragma unroll
        for (int k = 0; k < 4; ++k) {
            *(u32x4*)(di + 4 * k) = (u32x4){(unsigned)id[4 * k], (unsigned)id[4 * k + 1], (unsigned)id[4 * k + 2], (unsigned)id[4 * k + 3]};
            *(f32x4*)(dg + 4 * k) = (f32x4){e[4 * k] * inv, e[4 * k + 1] * inv, e[4 * k + 2] * inv, e[4 * k + 3] * inv};
        }
    }
}

DI void phase_peerq(const Params& P, char* smem, const BlkMap& bm) {
    char* ws = P.ws;
    const int tid = tid_fresh(), lane = tid & 63, wid = __builtin_amdgcn_readfirstlane(tid >> 6), wr = wid >> 2, wc = wid & 3, q4 = lane >> 4;
    const int gw = blockIdx.x * NWV + wid, nw = gridDim.x * NWV;
    const int gt = blockIdx.x * NTHR + tid, ntd = gridDim.x * NTHR;
    {
        unsigned* ub = (unsigned*)(ws + OFF_UB); unsigned* vb = (unsigned*)(ws + OFF_VB8);
        for (int idx = gt; idx < 16384 * 1024 / 16; idx += ntd) {
            const size_t e = (size_t)idx * 16; const int c = (int)(e & 1023);
            u32x4 uo, vo;
#pragma unroll
            for (int q = 0; q < 4; ++q) {
                const f32x4 g0 = *(const f32x4*)(P.ffn_g + c + 4 * q) * U8_SCALE;
                const f32x4 u0 = *(const f32x4*)(P.eu + e + 4 * q) * g0;
                const f32x4 v0 = *(const f32x4*)(P.ev + e + 4 * q) * V8_SCALE;
                uo[q] = pack_fp8x4(u0[0], u0[1], u0[2], u0[3]);
                vo[q] = pack_fp8x4(v0[0], v0[1], v0[2], v0[3]);
            }
            *(u32x4*)(ub + e / 4) = uo;
            *(u32x4*)(vb + e / 4) = vo;
        }
    }
    const bf16_t* x2b = (const bf16_t*)(ws + OFF_X2B); const bf16_t* wp = (const bf16_t*)(ws + OFF_WTPQ);
    constexpr int QIMG_STR = 528, QIMG_BYTES = 256 * QIMG_STR;
    constexpr int Mt = T / 256, Nt = 8;
    for (int v = tile_first(bm); v < tile_count(bm, Mt, Nt); v += tile_step(bm)) {
        int mt, nt; tile_map(bm, v, Mt, Nt, mt, nt);
        const int row0 = mt * 256, col0 = nt * 256;
        f32x4 acc[8][4];
        gemm_main<true>(x2b + (size_t)row0 * 1024, 1024, wp + (size_t)col0 * 1024, 1024, 1024, smem, acc);
        int lz = lane; asm volatile("" : "+v"(lz));
#pragma unroll
        for (int m = 0; m < 8; ++m) {
#pragma unroll
            for (int n = 0; n < 4; ++n) {
                const f32x4 v4 = acc[m][n];
                *(u32x2*)(smem + (128 * wr + 16 * m + (lz & 15)) * QIMG_STR + (64 * wc + 16 * n + 4 * (lz >> 4)) * 2) = (u32x2){pk_bf16(v4[0], v4[1]), pk_bf16(v4[2], v4[3])};
            }
        }
        __syncthreads();
        peer_topk_task(P, (const bf16_t*)(smem + (32 * wid + (lz & 31)) * QIMG_STR), (size_t)row0 + 32 * wid + (lz & 31), nt,
                       (unsigned*)(smem + QIMG_BYTES) + wid * 512 + lz * 8, lz & 31, lz >> 5);
    }
}

DI float reduce16(float (&p)[16], int lane) {
    const bool b5 = lane & 32, b4 = lane & 16, b3 = lane & 8, b2 = lane & 4;
    float r8[8], r4[4], r2[2];
#pragma unroll
    for (int i = 0; i < 8; ++i) { const float keep = b5 ? p[i + 8] : p[i], send = b5 ? p[i] : p[i + 8]; r8[i] = keep + __shfl_xor(send, 32); }
#pragma unroll
    for (int i = 0; i < 4; ++i) { const float keep = b4 ? r8[i + 4] : r8[i], send = b4 ? r8[i] : r8[i + 4]; r4[i] = keep + __shfl_xor(send, 16); }
#pragma unroll
    for (int i = 0; i < 2; ++i) { const float keep = b3 ? r4[i + 2] : r4[i], send = b3 ? r4[i] : r4[i + 2]; r2[i] = keep + __shfl_xor(send, 8); }
    const float keep = b2 ? r2[1] : r2[0], send = b2 ? r2[0] : r2[1];
    float r1 = keep + __shfl_xor(send, 4);
    r1 += __shfl_xor(r1, 2); r1 += __shfl_xor(r1, 1);
    return r1;
}
constexpr size_t OFF_PART = R1;
constexpr size_t OFF_SSQ = OFF_COSA;
DI bool slice_next(const BlkMap& bm, int it, int wid, int& t, int& x) {
    if (bm.ok) { t = bm.rank * NWV + wid + it * (32 * NWV); x = bm.xcd; return t < T; }
    const int p = (int)blockIdx.x * NWV + wid + it * (int)gridDim.x * NWV; t = p >> 3; x = p & 7; return p < T * 8;
}
DI void phase_exp_u(const Params& P, const BlkMap& bm) {
    char* ws = P.ws;
    const bf16_t* x2b = (const bf16_t*)(ws + OFF_X2B);
    const unsigned char* ub = (const unsigned char*)(ws + OFF_UB);
    const int* pidx = (const int*)(ws + OFF_PIDX);
    float* part = (float*)(ws + OFF_PART);
    const int tid = tid_fresh(), lane = tid & 63, wid = __builtin_amdgcn_readfirstlane(tid >> 6), g = lane >> 3, r = lane & 7;
    int t, x;
    for (int it = 0; slice_next(bm, it, wid, t, x); ++it) {
        f32x2 xv[8];
        {
            const bf16_t* xp = x2b + (size_t)t * 1024 + 128 * x + 16 * r;
            const u32x4 a = *(const u32x4*)xp, b = *(const u32x4*)(xp + 8);
#pragma unroll
            for (int j = 0; j < 4; ++j) { xv[j] = (f32x2){bf_lo(a[j]), bf_hi(a[j])}; xv[4 + j] = (f32x2){bf_lo(b[j]), bf_hi(b[j])}; }
        }
        int id[16];
#pragma unroll
        for (int q = 0; q < 4; ++q) { const u32x4 w = *(const u32x4*)(pidx + (size_t)t * 128 + g * 16 + 4 * q); id[4 * q] = (int)w[0]; id[4 * q + 1] = (int)w[1]; id[4 * q + 2] = (int)w[2]; id[4 * q + 3] = (int)w[3]; }
        u32x4 uu[16];
        const unsigned char* ubase = ub + 128 * x + 16 * r;
#pragma unroll
        for (int j = 0; j < 16; ++j) uu[j] = *(const u32x4*)(ubase + (size_t)id[j] * 1024);
        float p[16];
#pragma unroll
        for (int j = 0; j < 16; ++j) {
            f32x2 acc = {0.f, 0.f};
#pragma unroll
            for (int q = 0; q < 4; ++q) { acc = __builtin_elementwise_fma(fp8lo(uu[j][q]), xv[2 * q], acc); acc = __builtin_elementwise_fma(fp8hi(uu[j][q]), xv[2 * q + 1], acc); }
            p[j] = acc.x + acc.y;
        }
        const bool b4 = r & 4, b2 = r & 2, b1 = r & 1;
        float q8[8], q4v[4], q2[2];
#pragma unroll
        for (int i = 0; i < 8; ++i) { const float keep = b4 ? p[i + 8] : p[i], send = b4 ? p[i] : p[i + 8]; q8[i] = keep + dpp_get<0x1B>(dpp_get<0x141>(send)); }
#pragma unroll
        for (int i = 0; i < 4; ++i) { const float keep = b2 ? q8[i + 4] : q8[i], send = b2 ? q8[i] : q8[i + 4]; q4v[i] = keep + dpp_get<0x4E>(send); }
#pragma unroll
        for (int i = 0; i < 2; ++i) { const float keep = b1 ? q4v[i + 2] : q4v[i], send = b1 ? q4v[i] : q4v[i + 2]; q2[i] = keep + dpp_get<0xB1>(send); }
        *(f32x2*)(part + ((size_t)x * T + t) * 128 + 2 * lane) = (f32x2){q2[0], q2[1]};
    }
}
DI void phase_exp_w(const Params& P) {
    char* ws = P.ws;
    const float* ssq2 = (const float*)(ws + OFF_SSQ2);
    float* pg = (float*)(ws + OFF_PG);
    const float* part = (const float*)(ws + OFF_PART);
    const int tid = tid_fresh(), lane = tid & 63, wid = __builtin_amdgcn_readfirstlane(tid >> 6);
    const int gw = blockIdx.x * NWV + wid, nw = gridDim.x * NWV;
    for (int t = gw; t < T; t += nw) {
        f32x2 tot = {0.f, 0.f};
#pragma unroll
        for (int xx = 0; xx < 8; ++xx) tot += *(const f32x2*)(part + ((size_t)xx * T + t) * 128 + 2 * lane);
        const float r2 = rinv2_of(ssq2, t) * (1.0f / U8_SCALE);
        const f32x2 gg = *(const f32x2*)(pg + (size_t)t * 128 + 2 * lane);
        const float a0 = tot.x * r2, a1 = tot.y * r2;
        const float w0 = gg.x * 0.5f * a0 * (1.0f + erff(a0 * 0.70710678118654752f)) * (1.0f / V8_SCALE);
        const float w1 = gg.y * 0.5f * a1 * (1.0f + erff(a1 * 0.70710678118654752f)) * (1.0f / V8_SCALE);
        *(f32x2*)(pg + (size_t)t * 128 + 2 * lane) = (f32x2){w0, w1};
    }
}
DI void phase_exp_v(const Params& P, const BlkMap& bm, char* smem) {
    char* ws = P.ws;
    const float* x2 = (const float*)(ws + OFF_X2);
    const unsigned char* vb = (const unsigned char*)(ws + OFF_VB8);
    const float* rinv2 = (const float*)(ws + OFF_RINV2);
    const int* pidx = (const int*)(ws + OFF_PIDX); const float* pg = (const float*)(ws + OFF_PG);
    const float* part = (const float*)(ws + OFF_PART);
    float* ssq = (float*)(ws + OFF_SSQ);
    const int tid = tid_fresh(), lane = tid & 63, wid = __builtin_amdgcn_readfirstlane(tid >> 6), g = lane >> 3, r = lane & 7;
    int t, x;
    for (int it = 0; slice_next(bm, it, wid, t, x); ++it) {
        int id[16];
#pragma unroll
        for (int q = 0; q < 4; ++q) { const u32x4 w = *(const u32x4*)(pidx + (size_t)t * 128 + g * 16 + 4 * q); id[4 * q] = (int)w[0]; id[4 * q + 1] = (int)w[1]; id[4 * q + 2] = (int)w[2]; id[4 * q + 3] = (int)w[3]; }
        u32x4 vv[16];
        const unsigned char* vbase = vb + 128 * x + 16 * r;
#pragma unroll
        for (int j = 0; j < 16; ++j) vv[j] = *(const u32x4*)(vbase + (size_t)id[j] * 1024);
        float wj[16];
#pragma unroll
        for (int q = 0; q < 4; ++q) { const f32x4 w = *(const f32x4*)(pg + (size_t)t * 128 + g * 16 + 4 * q); wj[4 * q] = w[0]; wj[4 * q + 1] = w[1]; wj[4 * q + 2] = w[2]; wj[4 * q + 3] = w[3]; }
        f32x2 out[8];
#pragma unroll
        for (int i = 0; i < 8; ++i) out[i] = (f32x2){0.f, 0.f};
#pragma unroll
        for (int j = 0; j < 16; ++j) {
            const f32x2 w2 = {wj[j], wj[j]};
#pragma unroll
            for (int q = 0; q < 4; ++q) { out[2 * q] = __builtin_elementwise_fma(fp8lo(vv[j][q]), w2, out[2 * q]); out[2 * q + 1] = __builtin_elementwise_fma(fp8hi(vv[j][q]), w2, out[2 * q + 1]); }
        }
        float o[16];
#pragma unroll
        for (int i = 0; i < 8; ++i) { o[2 * i] = out[i].x; o[2 * i + 1] = out[i].y; }
        const bool b5 = lane & 32, b4 = lane & 16, b3 = lane & 8;
        float q8[8], q4v[4], q2[2];
#pragma unroll
        for (int i = 0; i < 8; ++i) q8[i] = swap_add32(o[i], o[i + 8]);
#pragma unroll
        for (int i = 0; i < 4; ++i) q4v[i] = swap_add16(q8[i], q8[i + 4]);
#pragma unroll
        for (int i = 0; i < 2; ++i) { const float keep = b3 ? q4v[i + 2] : q4v[i], send = b3 ? q4v[i] : q4v[i + 2]; q2[i] = keep + dpp_get<0x128>(send); }
        const size_t col = (size_t)t * 1024 + 128 * x + 16 * r + 2 * g;
        const f32x2 xr = *(const f32x2*)(x2 + col);
        const float y0 = xr.x + q2[0], y1 = xr.y + q2[1];
        *(f32x2*)(P.out + col) = (f32x2){y0, y1};
    }
}
DI void phase_final_norm(const Params& P) {
    const int tid = tid_fresh(), lane = tid & 63, wid = __builtin_amdgcn_readfirstlane(tid >> 6);
    const int gw = blockIdx.x * NWV + wid, nw = gridDim.x * NWV;
    for (int t = gw; t < T; t += nw) {
        float* o = P.out + (size_t)t * 1024;
        f32x4 y[4]; float ss = 0.f;
#pragma unroll
        for (int i = 0; i < 4; ++i) { y[i] = *(const f32x4*)(o + 4 * (lane + 64 * i)); ss += y[i][0] * y[i][0] + y[i][1] * y[i][1] + y[i][2] * y[i][2] + y[i][3] * y[i][3]; }
        ss = wave_sum(ss);
        const float rinv = rsqrtf(ss * (1.0f / DM) + RMS_EPS);
#pragma unroll
        for (int i = 0; i < 4; ++i) { const int c = 4 * (lane + 64 * i); *(f32x4*)(o + c) = y[i] * rinv * *(const f32x4*)(P.fin_g + c); }
    }
}

#define XB_TMO      128
#define XB_XCNT(j)  (256  + 64 * (j))
#define XB_XSUB(j)  (1280 + 64 * (j))
#define XB_XGEN(j)  (2304 + 64 * (j))
#define XB_TOP      3328
#define XB_TOPGEN   3392
#define XCD_BAR_WORDS 3456
#define XB_SPIN_CAP (1u << 18)
#define LAS __attribute__((address_space(3)))
DI unsigned xb_ld(unsigned* p)              { return __hip_atomic_load(p, __ATOMIC_RELAXED, __HIP_MEMORY_SCOPE_AGENT); }
DI unsigned xb_add(unsigned* p, unsigned v) { return __hip_atomic_fetch_add(p, v, __ATOMIC_RELAXED, __HIP_MEMORY_SCOPE_AGENT); }
#define XB_SPIN(cond, bar) do { unsigned _sp = 0; while (cond) { __builtin_amdgcn_s_sleep(1); \
    if ((++_sp & 255u) == 0u) { if (xb_ld(&(bar)[XB_TMO])) break; if (_sp > XB_SPIN_CAP) { atomicAdd(&(bar)[XB_TMO], 1u); break; } } } } while (0)
struct XcdBarrier { unsigned* bar; unsigned x; volatile LAS unsigned* st; };
DI XcdBarrier xcd_barrier_post(unsigned* bar, volatile LAS unsigned* st) {
    XcdBarrier b; b.bar = bar; b.x = (unsigned)__builtin_amdgcn_s_getreg((3 << 11) | 20) & 0xFu; b.st = st;
    if (threadIdx.x == 0) (void)xb_add(&bar[XB_XCNT(b.x)], 1u);
    return b;
}
DI void xcd_barrier_complete(unsigned* bar, unsigned x, unsigned& nloc, unsigned& nx) {
    const unsigned G = gridDim.x * gridDim.y * gridDim.z;
    unsigned sum, cnt, mine, sp = 0u;
    for (;;) {
        sum = 0u; cnt = 0u; mine = 0u;
#pragma unroll
        for (unsigned j = 0; j < 16; ++j) { const unsigned c = xb_ld(&bar[XB_XCNT(j)]); sum += c; cnt += (c > 0u) ? 1u : 0u; mine = (j == x) ? c : mine; }
        if (sum == G) break;
        __builtin_amdgcn_s_sleep(1);
        if ((++sp & 255u) == 0u) { if (xb_ld(&bar[XB_TMO])) break; if (sp > XB_SPIN_CAP) { atomicAdd(&bar[XB_TMO], 1u); break; } }
    }
    nloc = mine > 0u ? mine : 1u; nx = cnt > 0u ? cnt : 1u;
}
DI void xcd_barrier(const XcdBarrier& b) {
    asm volatile("s_waitcnt vmcnt(0)" ::: "memory");
    __syncthreads();
    if (threadIdx.x == 0) {
        unsigned* bar = b.bar;
        __builtin_amdgcn_s_waitcnt(0);
        unsigned nloc = b.st[0], nx = b.st[1];
        if (nloc == 0u) { xcd_barrier_complete(bar, b.x, nloc, nx); b.st[0] = nloc; b.st[1] = nx; }
        const unsigned old = xb_add(&bar[XB_XSUB(b.x)], 1u);
        const unsigned gen = old / nloc;
        if (old + 1u == (gen + 1u) * nloc) {
            __builtin_amdgcn_fence(__ATOMIC_RELEASE, "agent");
            asm volatile("s_waitcnt vmcnt(0)" ::: "memory");
            const unsigned og = xb_add(&bar[XB_TOP], 1u);
            const unsigned tg = og / nx;
            if (og + 1u == (tg + 1u) * nx) xb_add(&bar[XB_TOPGEN], 1u);
            else XB_SPIN(xb_ld(&bar[XB_TOPGEN]) == tg, bar);
            __builtin_amdgcn_fence(__ATOMIC_ACQUIRE, "agent");
            xb_add(&bar[XB_XGEN(b.x)], 1u);
            asm volatile("s_waitcnt vmcnt(0)" ::: "memory");
        } else {
            XB_SPIN(xb_ld(&bar[XB_XGEN(b.x)]) == gen, bar);
            __builtin_amdgcn_fence(__ATOMIC_ACQUIRE, "agent");
            asm volatile("s_waitcnt vmcnt(0)" ::: "memory");
        }
    }
    __syncthreads();
}

constexpr int SMEM_BYTES = 152 * 1024;
constexpr int XB_ST_OFF = 150 * 1024;
template <bool COOP>
__global__ void __launch_bounds__(512) hybrid_fwd(Params P, int ph_lo, int ph_hi) {
    extern __shared__ __attribute__((aligned(16))) char smem[];
#ifndef PROBE_REP
#define PROBE_REP 0
#endif
    volatile LAS unsigned* xst = (volatile LAS unsigned*)(smem + XB_ST_OFF);
    if (threadIdx.x == 0) { xst[0] = 0u; xst[1] = 0u; xst[2] = 0u; xst[3] = 0u; }
    __syncthreads();
    XcdBarrier xb; xb.bar = (unsigned*)(P.ws + OFF_CTR) + 256; xb.x = 0u; xb.st = xst;
    if (COOP) xb = xcd_barrier_post((unsigned*)(P.ws + OFF_CTR) + 256, xst);
    BlkMap bm; bm.xcd = 0; bm.rank = 0; bm.cnt = 1; bm.ok = 0;
    unsigned* census = (unsigned*)(P.ws + OFF_CTR) + 16;
    if (COOP) {
        bm.xcd = (int)xcc_id() & 7;
        if (threadIdx.x == 0) *(int*)smem = (int)atomicAdd(census + bm.xcd, 1u);
        __syncthreads();
        bm.rank = __builtin_amdgcn_readfirstlane(*(int*)smem);
        __syncthreads();
    }
#define RUN_PHASE(k, call) do { if (COOP || (ph_lo <= (k) && (k) <= ph_hi)) { if (COOP && (k) == 1) cg::this_grid().sync(); else if (COOP && (k) > 1) xcd_barrier(xb); \
        if (COOP && (k) == 1) { int okk = 1; const int per = (int)gridDim.x >> 3; for (int x_ = 0; x_ < 8; ++x_) okk &= ((int)census[x_] == per); \
            bm.cnt = per; bm.ok = okk && ((gridDim.x & 7) == 0) && per == 32; } \
        call; \
        if (COOP && ((PROBE_REP >> (k)) & 1)) { cg::this_grid().sync(); if ((k) == 3) phase_attn(P, smem, 1); else { call; } } } } while (0)
    RUN_PHASE(0, phase_prep(P));
    RUN_PHASE(1, phase_inproj(P, smem, bm));
    RUN_PHASE(2, phase_mla_up(P, smem));
    RUN_PHASE(3, phase_attn(P, smem));
    RUN_PHASE(4, phase_merge(P, smem, bm));
    RUN_PHASE(5, phase_outproj(P, smem, bm));
    RUN_PHASE(6, phase_peerq(P, smem, bm));
    RUN_PHASE(8, phase_exp_u(P, bm));
    RUN_PHASE(9, phase_exp_w(P));
    RUN_PHASE(10, phase_exp_v(P, bm, smem));
    RUN_PHASE(11, phase_final_norm(P));
#undef RUN_PHASE
}

extern "C" void kernel_launch(void* const* d_in, const int* in_sizes, int n_in, void* d_out, int out_size, void* d_ws, size_t ws_size, hipStream_t stream) {
    Params p{};
    p.x = (const float*)d_in[0]; p.pos = (const int*)d_in[1]; p.mix_g = (const float*)d_in[2]; p.w_in = (const float*)d_in[3];
    p.qn_g = (const float*)d_in[4]; p.w_qup = (const float*)d_in[5]; p.kvn_g = (const float*)d_in[6]; p.w_kvup = (const float*)d_in[7];
    p.w_a = (const float*)d_in[8]; p.w_b = (const float*)d_in[9]; p.w_out = (const float*)d_in[10]; p.ffn_g = (const float*)d_in[11];
    p.w_pq = (const float*)d_in[12]; p.keys1 = (const float*)d_in[13]; p.keys2 = (const float*)d_in[14]; p.eu = (const float*)d_in[15];
    p.ev = (const float*)d_in[16]; p.fin_g = (const float*)d_in[17];
    p.out = (float*)d_out; p.ws = (char*)d_ws;
    static int grid_blocks = 0;
    if (!grid_blocks) {
        int dev = 0, cus = 0, per_cu = 0;
        hipGetDevice(&dev);
        hipDeviceGetAttribute(&cus, hipDeviceAttributeMultiprocessorCount, dev);
#if MK_COOP
        hipFuncSetAttribute((const void*)hybrid_fwd<true>, hipFuncAttributeMaxDynamicSharedMemorySize, SMEM_BYTES);
        hipOccupancyMaxActiveBlocksPerMultiprocessor(&per_cu, hybrid_fwd<true>, NTHR, SMEM_BYTES);
#else
        hipFuncSetAttribute((const void*)hybrid_fwd<false>, hipFuncAttributeMaxDynamicSharedMemorySize, SMEM_BYTES);
        hipOccupancyMaxActiveBlocksPerMultiprocessor(&per_cu, hybrid_fwd<false>, NTHR, SMEM_BYTES);
#endif
        if (per_cu < 1) per_cu = 1;
        grid_blocks = cus * per_cu;
    }
#if MK_COOP
    hipMemsetAsync((char*)d_ws + OFF_CTR, 0, CTR_MEMSET_BYTES, stream);
    int lo = 0, hi = 11;
    void* args[] = {&p, &lo, &hi};
    hipError_t e = hipLaunchCooperativeKernel((void*)hybrid_fwd<true>, dim3(grid_blocks), dim3(NTHR), args, SMEM_BYTES, stream);
    if (e != hipSuccess) fprintf(stderr, "cooperative launch failed: %s (grid %d)\n", hipGetErrorString(e), grid_blocks);
#else
    hipMemsetAsync((char*)d_ws + OFF_CTR, 0, CTR_MEMSET_BYTES, stream);
    for (int ph = 0; ph <= 11; ++ph) hipLaunchKernelGGL(hybrid_fwd<false>, dim3(grid_blocks), dim3(NTHR), SMEM_BYTES, stream, p, ph, ph);
#endif
}
```

```cpp
#include <hip/hip_runtime.h>
#include <hip/hip_cooperative_groups.h>
#include <cstdio>
#include <cstdint>
namespace cg = cooperative_groups;

#ifndef MK_COOP
#define MK_COOP 1
#endif

typedef unsigned short bf16_t;
typedef short bf16x8 __attribute__((ext_vector_type(8)));
typedef float f32x4 __attribute__((ext_vector_type(4)));
typedef float f32x16 __attribute__((ext_vector_type(16)));
typedef unsigned u32x4 __attribute__((ext_vector_type(4)));
typedef unsigned u32x2 __attribute__((ext_vector_type(2)));
typedef __bf16 bf16x2_t __attribute__((ext_vector_type(2)));

#define DI __device__ __forceinline__

constexpr int T = 32768, SEQ = 4096, DM = 1024;
constexpr int NTHR = 512, NWV = 8;
constexpr int XB_LD = 1088;
constexpr float RMS_EPS = 1e-6f;
constexpr float LOG2E = 1.4426950408889634f;
constexpr float QS_A = 0.125f * LOG2E;
constexpr float QS_B = 0.10206207261596577f * LOG2E;

constexpr size_t MiB = 1ull << 20;
constexpr size_t OFF_WTIN = 0;
constexpr size_t OFF_WTQUP = 8 * MiB;
constexpr size_t OFF_WTKVUP = 8 * MiB + 512 * 1024;
constexpr size_t OFF_WTA = 9 * MiB;
constexpr size_t OFF_WTB = 10 * MiB;
constexpr size_t OFF_WTOUT = 11 * MiB;
constexpr size_t OFF_WTPQ = 13 * MiB;
constexpr size_t OFF_KEYS = 17 * MiB;
constexpr size_t OFF_COSA = 18 * MiB;
constexpr size_t OFF_SINA = 22 * MiB;
constexpr size_t OFF_COSB = 26 * MiB;
constexpr size_t OFF_SINB = 28 * MiB;
constexpr size_t OFF_RINV1 = 30 * MiB;
constexpr size_t OFF_RINV2 = 30 * MiB + 128 * 1024;
constexpr size_t OFF_KMEAN = 30 * MiB + 256 * 1024;
constexpr size_t OFF_CTR = 30 * MiB + 512 * 1024;
constexpr size_t OFF_SSQ2 = OFF_CTR + 32 * 1024;
constexpr size_t CTR_MEMSET_BYTES = 160 * 1024;
constexpr size_t R1 = 31 * MiB;
constexpr size_t OFF_XB = R1;
constexpr size_t OFF_QN = R1;
constexpr size_t OFF_KN = R1 + 32 * MiB;
constexpr size_t OFF_VBT = R1 + 64 * MiB;
constexpr size_t OFF_QPE = R1 + 96 * MiB;
constexpr size_t R2 = 143 * MiB;
constexpr size_t OFF_QA = R2;
constexpr size_t OFF_KA = R2 + 32 * MiB;
constexpr size_t OFF_VAT = R2 + 64 * MiB;
constexpr size_t OFF_CQ = R2 + 96 * MiB;
constexpr size_t OFF_CKV = R2 + 112 * MiB;
constexpr size_t OFF_KPE = R2 + 120 * MiB;
constexpr size_t OFF_GA = 265 * MiB;
constexpr size_t OFF_GB = 329 * MiB;
constexpr size_t OFF_YA = 393 * MiB;
constexpr size_t OFF_YB = 425 * MiB;
constexpr size_t OFF_MERGED = R2;
constexpr size_t OFF_X2 = OFF_GA;
constexpr size_t OFF_X2B = OFF_YA;
constexpr size_t OFF_QP = R1;
constexpr size_t OFF_PIDX = R1 + 128 * MiB;
constexpr size_t OFF_PG = R1 + 144 * MiB;
constexpr size_t OFF_UB = R1 + 160 * MiB;
constexpr size_t OFF_VB = R1 + 192 * MiB;
constexpr size_t OFF_VB8 = R1 + 176 * MiB;
static_assert(OFF_VB + 32 * MiB <= OFF_GA, "overlay");

struct Params {
    const float* x; const int* pos; const float* mix_g; const float* w_in; const float* qn_g; const float* w_qup;
    const float* kvn_g; const float* w_kvup; const float* w_a; const float* w_b; const float* w_out; const float* ffn_g;
    const float* w_pq; const float* keys1; const float* keys2; const float* eu; const float* ev; const float* fin_g;
    float* out; char* ws;
};

typedef float f32x2 __attribute__((ext_vector_type(2)));
DI unsigned pk_bf16(float lo, float hi) { const f32x2 v = {lo, hi}; return __builtin_bit_cast(unsigned, __builtin_convertvector(v, bf16x2_t)); }
DI bf16_t f2bf(float x) { return (bf16_t)(pk_bf16(x, x) & 0xffffu); }
DI float bf_lo(unsigned w) { return __uint_as_float(w << 16); }
DI float bf_hi(unsigned w) { return __uint_as_float(w & 0xffff0000u); }
DI int tid_fresh() { int t = threadIdx.x; asm volatile("" : "+v"(t)); return t; }
DI float swap_add32(float a, float b) { const u32x2 r = __builtin_amdgcn_permlane32_swap(__float_as_uint(a), __float_as_uint(b), false, false); return __uint_as_float(r[0]) + __uint_as_float(r[1]); }
DI float swap_add16(float a, float b) { const u32x2 r = __builtin_amdgcn_permlane16_swap(__float_as_uint(a), __float_as_uint(b), false, false); return __uint_as_float(r[0]) + __uint_as_float(r[1]); }
template <int CTRL> DI float dpp_get(float v) { return __int_as_float(__builtin_amdgcn_update_dpp(0, __float_as_int(v), CTRL, 0xf, 0xf, false)); }
DI float wave_sum(float v) {
#pragma unroll
    for (int o = 32; o >= 1; o >>= 1) v += __shfl_xor(v, o);
    return v;
}
DI float fdot2(unsigned a, unsigned b, float c) { return __builtin_amdgcn_fdot2_f32_bf16(__builtin_bit_cast(bf16x2_t, a), __builtin_bit_cast(bf16x2_t, b), c, false); }
DI float dot8(const u32x4& a, const u32x4& b, float c) { c = fdot2(a.x, b.x, c); c = fdot2(a.y, b.y, c); c = fdot2(a.z, b.z, c); c = fdot2(a.w, b.w, c); return c; }
DI f32x2 fp8lo(unsigned w) { return __builtin_amdgcn_cvt_pk_f32_fp8((int)w, false); }
DI f32x2 fp8hi(unsigned w) { return __builtin_amdgcn_cvt_pk_f32_fp8((int)w, true); }
DI unsigned pack_fp8x4(float a, float b, float c, float d) { int r = 0; r = __builtin_amdgcn_cvt_pk_fp8_f32(a, b, r, false); r = __builtin_amdgcn_cvt_pk_fp8_f32(c, d, r, true); return (unsigned)r; }
constexpr float U8_SCALE = 64.0f, V8_SCALE = 16.0f;
#define MFMA16(a, b, c) __builtin_amdgcn_mfma_f32_16x16x32_bf16((a), (b), (c), 0, 0, 0)
#define MFMA32(a, b, c) __builtin_amdgcn_mfma_f32_32x32x16_bf16((a), (b), (c), 0, 0, 0)

template <class F>
DI void transpose_w(const float* __restrict__ W, int ldw, int K, int Nd, const float* __restrict__ g, bf16_t* __restrict__ Wt, F srccol, int gw, int nw, int lane) {
    const int nbn = Nd / 64, ntask = nbn * (K / 32);
    for (int task = gw; task < ntask; task += nw) {
        const int nb = task % nbn, kb = task / nbn;
        const int nd = nb * 64 + lane, sc = srccol(nd);
        unsigned w[16];
#pragma unroll
        for (int j = 0; j < 16; ++j) {
            const int k = kb * 32 + 2 * j;
            float a = 0.f, b = 0.f;
            if (sc >= 0) { a = W[(size_t)k * ldw + sc]; b = W[(size_t)(k + 1) * ldw + sc]; if (g) { a *= g[k]; b *= g[k + 1]; } }
            w[j] = pk_bf16(a, b);
        }
        u32x4* dst = (u32x4*)(Wt + (size_t)nd * K + kb * 32);
#pragma unroll
        for (int j = 0; j < 4; ++j) dst[j] = (u32x4){w[4 * j], w[4 * j + 1], w[4 * j + 2], w[4 * j + 3]};
    }
}

DI void phase_prep(const Params& P) {
    char* ws = P.ws;
    const int tid = tid_fresh(), lane = tid & 63;
    const int gw = blockIdx.x * NWV + (tid >> 6), nw = gridDim.x * NWV;
    const int gt = blockIdx.x * NTHR + tid, nt = gridDim.x * NTHR;
    {
        bf16_t* xb = (bf16_t*)(ws + OFF_XB); float* rinv1 = (float*)(ws + OFF_RINV1);
        for (int t = gw; t < T; t += nw) {
            const f32x4* src = (const f32x4*)(P.x + (size_t)t * DM);
            f32x4 v[4]; float ss = 0.f;
#pragma unroll
            for (int i = 0; i < 4; ++i) { v[i] = src[lane + 64 * i]; ss += v[i][0] * v[i][0] + v[i][1] * v[i][1] + v[i][2] * v[i][2] + v[i][3] * v[i][3]; }
            ss = wave_sum(ss);
            if (lane == 0) rinv1[t] = rsqrtf(ss * (1.0f / DM) + RMS_EPS);
            u32x2* dst = (u32x2*)(xb + (size_t)t * XB_LD);
#pragma unroll
            for (int i = 0; i < 4; ++i) dst[lane + 64 * i] = (u32x2){pk_bf16(v[i][0], v[i][1]), pk_bf16(v[i][2], v[i][3])};
        }
    }
    {
        float* cosA = (float*)(ws + OFF_COSA); float* sinA = (float*)(ws + OFF_SINA);
        float* cosB = (float*)(ws + OFF_COSB); float* sinB = (float*)(ws + OFF_SINB);
        const int i = gt & 31;
        const float fa = powf(10000.0f, -(float)(2 * i) / 64.0f);
        const float fb = powf(10000.0f, -(float)(2 * (i & 15)) / 32.0f);
        for (int idx = gt; idx < T * 32; idx += nt) {
            const int t = idx >> 5;
            const float pos = (float)P.pos[t];
            float sa, ca; sincosf(pos * fa, &sa, &ca);
            cosA[idx] = ca; sinA[idx] = sa;
            if (i < 16) {
                float sb, cb; sincosf(pos * fb, &sb, &cb);
                cosB[t * 16 + i] = cb; sinB[t * 16 + i] = sb;
            }
        }
    }
    transpose_w(P.w_in, 4000, 1024, 4096, P.mix_g, (bf16_t*)(ws + OFF_WTIN),
                [](int n) { return n < 1920 ? n : (n < 3968 ? n + 32 : (n < 4000 ? n - 3968 + 1920 : -1)); }, gw, nw, lane);
    transpose_w(P.w_qup, 768, 256, 768, P.qn_g, (bf16_t*)(ws + OFF_WTQUP),
                [](int n) { return n < 512 ? (n >> 6) * 96 + (n & 63) : ((n - 512) >> 5) * 96 + 64 + ((n - 512) & 31); }, gw, nw, lane);
    transpose_w(P.w_kvup, 1024, 128, 1024, P.kvn_g, (bf16_t*)(ws + OFF_WTKVUP),
                [](int n) { return n < 512 ? (n >> 6) * 128 + (n & 63) : ((n - 512) >> 6) * 128 + 64 + ((n - 512) & 63); }, gw, nw, lane);
    transpose_w(P.w_a, 1024, 512, 1024, nullptr, (bf16_t*)(ws + OFF_WTA), [](int n) { return n; }, gw, nw, lane);
    transpose_w(P.w_b, 1024, 512, 1024, nullptr, (bf16_t*)(ws + OFF_WTB), [](int n) { return n; }, gw, nw, lane);
    transpose_w(P.w_out, 1024, 1024, 1024, nullptr, (bf16_t*)(ws + OFF_WTOUT), [](int n) { return n; }, gw, nw, lane);
    transpose_w(P.w_pq, 2048, 1024, 2048, P.ffn_g, (bf16_t*)(ws + OFF_WTPQ), [](int n) { return n; }, gw, nw, lane);
    {
        bf16_t* kb = (bf16_t*)(ws + OFF_KEYS);
        for (int idx = gt; idx < 2 * 131072 / 4; idx += nt) {
            const int e = idx * 4; const float* src = e < 131072 ? P.keys1 + e : P.keys2 + (e - 131072);
            const f32x4 v = *(const f32x4*)src;
            *(u32x2*)(kb + e) = (u32x2){pk_bf16(v[0], v[1]), pk_bf16(v[2], v[3])};
        }
    }
}

constexpr int LSTR = 72;
constexpr int GEMM_LDS = 2 * 256 * LSTR * 2;
#define LDS_BARRIER() do { asm volatile("s_waitcnt lgkmcnt(0)" ::: "memory"); __builtin_amdgcn_s_barrier(); asm volatile("" ::: "memory"); } while (0)
#define LAS3 __attribute__((address_space(3)))
constexpr int GSTAGE = 65536;
template <bool ZERO>
DI void gemm_main(const bf16_t* __restrict__ A, int lda, const bf16_t* __restrict__ Bt, int ldb, int K, char* smem, f32x4 (&acc)[8][4]) {
    const int tid = tid_fresh(), lane = tid & 63, wid = __builtin_amdgcn_readfirstlane(tid >> 6), wr = wid >> 2, wc = wid & 3;
    const char* Ab = (const char*)A; const char* Bb = (const char*)Bt;
    unsigned aoff[4], boff[4];
#pragma unroll
    for (int i = 0; i < 4; ++i) {
        const int row = 8 * (wid + 8 * i) + (lane >> 3), c = (lane & 7) ^ ((row >> 1) & 7);
        aoff[i] = (unsigned)(row * lda + c * 8) * 2u; boff[i] = (unsigned)(row * ldb + c * 8) * 2u;
    }
#define GM_DMA(buf, kk) do { const char* a_ = Ab + (size_t)(kk) * 2; const char* b_ = Bb + (size_t)(kk) * 2; \
        _Pragma("unroll") for (int i = 0; i < 4; ++i) __builtin_amdgcn_global_load_lds((const unsigned*)(a_ + aoff[i]), (LAS3 unsigned*)(smem + (buf) * GSTAGE + (wid + 8 * i) * 1024), 16, 0, 0); \
        _Pragma("unroll") for (int i = 0; i < 4; ++i) __builtin_amdgcn_global_load_lds((const unsigned*)(b_ + boff[i]), (LAS3 unsigned*)(smem + (buf) * GSTAGE + 32768 + (wid + 8 * i) * 1024), 16, 0, 0); } while (0)
    if (ZERO) {
#pragma unroll
        for (int m = 0; m < 8; ++m)
#pragma unroll
            for (int n = 0; n < 4; ++n) acc[m][n] = (f32x4){0.f, 0.f, 0.f, 0.f};
    }
    const int sw = (lane & 15) >> 1, q4 = lane >> 4;
    const int abase = (128 * wr + (lane & 15)) * 128, bbase = 32768 + (64 * wc + (lane & 15)) * 128;
    const int sl0 = ((q4) ^ sw) * 16, sl1 = ((4 + q4) ^ sw) * 16;
    LDS_BARRIER();
    GM_DMA(0, 0);
    asm volatile("s_waitcnt vmcnt(0)" ::: "memory");
    LDS_BARRIER();
#pragma unroll 1
    for (int k0 = 0; k0 < K; k0 += 64) {
        const int cur = (k0 >> 6) & 1;
        if (k0 + 64 < K) GM_DMA(cur ^ 1, k0 + 64);
        const char* Sb = smem + cur * GSTAGE;
        bf16x8 bf0[4], bf1[4], afA[4], afB[4];
#define LD_B(dst, sl) do { _Pragma("unroll") for (int n = 0; n < 4; ++n) dst[n] = *(const bf16x8*)(Sb + bbase + n * 2048 + (sl)); } while (0)
#define LD_A(dst, mh, sl) do { _Pragma("unroll") for (int m = 0; m < 4; ++m) dst[m] = *(const bf16x8*)(Sb + abase + (4 * (mh) + m) * 2048 + (sl)); } while (0)
#define MM(mh, af, bf) do { _Pragma("unroll") for (int m = 0; m < 4; ++m) _Pragma("unroll") for (int n = 0; n < 4; ++n) acc[4 * (mh) + m][n] = MFMA16(bf[n], af[m], acc[4 * (mh) + m][n]); } while (0)
        LD_B(bf0, sl0); LD_A(afA, 0, sl0);
        __builtin_amdgcn_sched_barrier(0);
        LD_A(afB, 1, sl0);
        __builtin_amdgcn_sched_barrier(0);
        MM(0, afA, bf0);
        __builtin_amdgcn_sched_barrier(0);
        LD_B(bf1, sl1); LD_A(afA, 0, sl1);
        __builtin_amdgcn_sched_barrier(0);
        MM(1, afB, bf0);
        __builtin_amdgcn_sched_barrier(0);
        LD_A(afB, 1, sl1);
        __builtin_amdgcn_sched_barrier(0);
        MM(0, afA, bf1);
        __builtin_amdgcn_sched_barrier(0);
        MM(1, afB, bf1);
        __builtin_amdgcn_sched_barrier(0);
#undef LD_B
#undef LD_A
#undef MM
        asm volatile("s_waitcnt vmcnt(0)" ::: "memory");
        LDS_BARRIER();
    }
#undef GM_DMA
}

struct BlkMap { int xcd, rank, cnt, ok; };
DI unsigned xcc_id() { return (unsigned)__builtin_amdgcn_s_getreg((3 << 11) | 20) & 0xFu; }
DI int tile_count(const BlkMap& bm, int Mt, int Nt) { return bm.ok ? (Mt * Nt) >> 3 : Mt * Nt; }
DI int tile_first(const BlkMap& bm) { return bm.ok ? bm.rank : (int)blockIdx.x; }
DI int tile_step(const BlkMap& bm) { return bm.ok ? bm.cnt : (int)gridDim.x; }
DI void tile_map(const BlkMap& bm, int j, int Mt, int Nt, int& mt, int& nt) {
    if (bm.ok) {
        const int slot = j & 31, sid = (j >> 5) * 8 + bm.xcd, snn = Nt >> 2;
        const int sm = sid / snn, sn = sid % snn;
        mt = 8 * sm + (slot >> 2); nt = 4 * sn + (slot & 3);
    } else { mt = j / Nt; nt = j % Nt; }
}

constexpr int WST = 144;
constexpr int WST_BYTES = 128 * WST;
DI void stg_put(char* wl, int lrow, int lcol, const f32x4& v) { *(u32x2*)(wl + lrow * WST + lcol * 2) = (u32x2){pk_bf16(v[0], v[1]), pk_bf16(v[2], v[3])}; }
DI void stg_flush(char* wl, bf16_t* dst, size_t ld, int lane, int ncols = 64) {
    asm volatile("" : "+v"(lane) :: "memory");
    const int rr = lane >> 3, ch = lane & 7;
#pragma unroll 4
    for (int j = 0; j < 16; ++j) {
        const int row = 8 * j + rr;
        const u32x4 w = *(const u32x4*)(wl + row * WST + ch * 16);
        if (ch * 8 < ncols) *(u32x4*)(dst + (size_t)row * ld + ch * 8) = w;
    }
    asm volatile("" ::: "memory");
}
DI void st4(bf16_t* dst, const f32x4& v) { *(u32x2*)dst = (u32x2){pk_bf16(v[0], v[1]), pk_bf16(v[2], v[3])}; }

DI void phase_inproj(const Params& P, char* smem, const BlkMap& bm) {
    char* ws = P.ws;
    const bf16_t* xb = (const bf16_t*)(ws + OFF_XB); const bf16_t* wt = (const bf16_t*)(ws + OFF_WTIN);
    const float* rinv1 = (const float*)(ws + OFF_RINV1);
    const float* cosA = (const float*)(ws + OFF_COSA); const float* sinA = (const float*)(ws + OFF_SINA);
    const float* cosB = (const float*)(ws + OFF_COSB); const float* sinB = (const float*)(ws + OFF_SINB);
    bf16_t* qa = (bf16_t*)(ws + OFF_QA); bf16_t* ka = (bf16_t*)(ws + OFF_KA); bf16_t* vaT = (bf16_t*)(ws + OFF_VAT);
    bf16_t* cq = (bf16_t*)(ws + OFF_CQ); bf16_t* ckv = (bf16_t*)(ws + OFF_CKV); bf16_t* kpe = (bf16_t*)(ws + OFF_KPE);
    bf16_t* ga = (bf16_t*)(ws + OFF_GA); bf16_t* gb = (bf16_t*)(ws + OFF_GB);
    const int tid = tid_fresh(), lane = tid & 63, wid = __builtin_amdgcn_readfirstlane(tid >> 6), wr = wid >> 2, wc = wid & 3, q4 = lane >> 4;
    constexpr int Mt = T / 256, Nt = 16;
    for (int v = tile_first(bm); v < tile_count(bm, Mt, Nt); v += tile_step(bm)) {
        int mt, nt; tile_map(bm, v, Mt, Nt, mt, nt);
        const int row0 = mt * 256, col0 = nt * 256;
        f32x4 acc[8][4];
        gemm_main<true>(xb + (size_t)row0 * XB_LD, XB_LD, wt + (size_t)col0 * DM, DM, DM, smem, acc);
        const int cb = col0 + 64 * wc;
        char* wl = smem + wid * WST_BYTES;
        const size_t tw0 = (size_t)row0 + 128 * wr;
        const int lr0 = lane & 15;
        if (cb < 1024) {
            const bool isq = cb < 512;
#pragma unroll
            for (int m = 0; m < 8; ++m) {
                const size_t t = tw0 + 16 * m + lr0;
                const float sc = isq ? rinv1[t] * QS_A : rinv1[t];
#pragma unroll
                for (int n = 0; n < 2; ++n) {
                    const f32x4 c = *(const f32x4*)(cosA + t * 32 + 16 * n + 4 * q4), s = *(const f32x4*)(sinA + t * 32 + 16 * n + 4 * q4);
                    const f32x4 x1 = acc[m][n] * sc, x2 = acc[m][n + 2] * sc;
                    stg_put(wl, 16 * m + lr0, 16 * n + 4 * q4, x1 * c - x2 * s);
                    stg_put(wl, 16 * m + lr0, 32 + 16 * n + 4 * q4, x2 * c + x1 * s);
                }
                asm volatile("" ::: "memory");
            }
            stg_flush(wl, (isq ? qa : ka) + tw0 * 512 + (cb & 511), 512, lane);
        } else if (cb < 1536) {
            const int h = (cb - 1024) >> 6;
#pragma unroll
            for (int m = 0; m < 8; ++m) {
                const int t = (int)tw0 + 16 * m + lr0;
                const float r = rinv1[t];
                const int b = t >> 12, s = t & 4095;
                bf16_t* dst = vaT + ((size_t)(b * 8 + h) * 64 + 4 * q4) * SEQ + s;
#pragma unroll
                for (int n = 0; n < 4; ++n)
#pragma unroll
                    for (int i = 0; i < 4; ++i) dst[(size_t)(16 * n + i) * SEQ] = f2bf(acc[m][n][i] * r);
            }
        } else if (cb < 1920) {
#pragma unroll
            for (int m = 0; m < 8; ++m) {
                const float r = rinv1[tw0 + 16 * m + lr0];
#pragma unroll
                for (int n = 0; n < 4; ++n) stg_put(wl, 16 * m + lr0, 16 * n + 4 * q4, acc[m][n] * r);
                asm volatile("" ::: "memory");
            }
            if (cb < 1792) stg_flush(wl, cq + tw0 * 256 + (cb - 1536), 256, lane);
            else stg_flush(wl, ckv + tw0 * 128 + (cb - 1792), 128, lane);
        } else if (cb < 3968) {
#pragma unroll
            for (int m = 0; m < 8; ++m) {
                const float r = rinv1[tw0 + 16 * m + lr0];
#pragma unroll
                for (int n = 0; n < 4; ++n) {
                    f32x4 z = acc[m][n] * r, o;
#pragma unroll
                    for (int i = 0; i < 4; ++i) o[i] = __builtin_amdgcn_rcpf(1.0f + __expf(-z[i]));
                    stg_put(wl, 16 * m + lr0, 16 * n + 4 * q4, o);
                }
                asm volatile("" ::: "memory");
            }
            stg_flush(wl, (cb < 2944 ? ga + tw0 * 1024 + (cb - 1920) : gb + tw0 * 1024 + (cb - 2944)), 1024, lane);
        } else if (cb == 3968) {
#pragma unroll
            for (int m = 0; m < 8; ++m) {
                const size_t t = tw0 + 16 * m + lr0;
                const float r = rinv1[t];
                const f32x4 c = *(const f32x4*)(cosB + t * 16 + 4 * q4), s = *(const f32x4*)(sinB + t * 16 + 4 * q4);
                const f32x4 x1 = acc[m][0] * r, x2 = acc[m][1] * r;
                stg_put(wl, 16 * m + lr0, 4 * q4, x1 * c - x2 * s);
                stg_put(wl, 16 * m + lr0, 16 + 4 * q4, x2 * c + x1 * s);
                asm volatile("" ::: "memory");
            }
            stg_flush(wl, kpe + tw0 * 32, 32, lane, 32);
        }
    }
}

DI void row_rinv256(const bf16_t* __restrict__ A, int lda, int K, float* s_rinv) {
    const int tid = tid_fresh(), row = tid >> 1, hf = tid & 1;
    const u32x4* p = (const u32x4*)(A + (size_t)row * lda + hf * (K / 2));
    float ss = 0.f;
    for (int c = 0; c < K / 16; ++c) {
        const u32x4 w = p[c];
#pragma unroll
        for (int j = 0; j < 4; ++j) { const float a = bf_lo(w[j]), b = bf_hi(w[j]); ss += a * a + b * b; }
    }
    ss += __shfl_xor(ss, 1);
    if (!hf) s_rinv[row] = rsqrtf(ss / (float)K + RMS_EPS);
}

DI void phase_mla_up(const Params& P, char* smem) {
    char* ws = P.ws;
    const bf16_t* cq = (const bf16_t*)(ws + OFF_CQ); const bf16_t* ckv = (const bf16_t*)(ws + OFF_CKV);
    const bf16_t* wq = (const bf16_t*)(ws + OFF_WTQUP); const bf16_t* wkv = (const bf16_t*)(ws + OFF_WTKVUP);
    const float* cosB = (const float*)(ws + OFF_COSB); const float* sinB = (const float*)(ws + OFF_SINB);
    bf16_t* qn = (bf16_t*)(ws + OFF_QN); bf16_t* qpe = (bf16_t*)(ws + OFF_QPE); bf16_t* kn = (bf16_t*)(ws + OFF_KN); bf16_t* vbT = (bf16_t*)(ws + OFF_VBT);
    const bf16_t* ka = (const bf16_t*)(ws + OFF_KA); float* kmean = (float*)(ws + OFF_KMEAN);
    float* s_rinv = (float*)(smem + 2 * GEMM_LDS);
    char* wl = smem + (threadIdx.x >> 6) * WST_BYTES;
    const int tid = tid_fresh(), lane = tid & 63, wid = __builtin_amdgcn_readfirstlane(tid >> 6), wr = wid >> 2, wc = wid & 3, q4 = lane >> 4;
    constexpr int Mt = T / 256;
    constexpr int N_Q = Mt * 3, N_KV = Mt * 4, N_KM = 128;
    for (int v = blockIdx.x; v < N_Q; v += gridDim.x) {
        __syncthreads();
        {
            const int mt = v / 3, nt = v % 3, row0 = mt * 256, col0 = nt * 256;
            row_rinv256(cq + (size_t)row0 * 256, 256, 256, s_rinv);
            f32x4 acc[8][4];
            gemm_main<true>(cq + (size_t)row0 * 256, 256, wq + (size_t)col0 * 256, 256, 256, smem, acc);
            const int cb = col0 + 64 * wc;
#pragma unroll
            for (int m = 0; m < 8; ++m) {
                const int lr = 128 * wr + 16 * m + (lane & 15), t = row0 + lr;
                const float r = s_rinv[lr] * QS_B;
                if (cb < 512) {
#pragma unroll
                    for (int n = 0; n < 4; ++n) stg_put(wl, lr - 128 * wr, 16 * n + 4 * q4, acc[m][n] * r);
                } else {
                    const f32x4 c = *(const f32x4*)(cosB + (size_t)t * 16 + 4 * q4), s = *(const f32x4*)(sinB + (size_t)t * 16 + 4 * q4);
#pragma unroll
                    for (int pr = 0; pr < 2; ++pr) {
                        const f32x4 x1 = acc[m][2 * pr] * r, x2 = acc[m][2 * pr + 1] * r;
                        stg_put(wl, lr - 128 * wr, 32 * pr + 4 * q4, x1 * c - x2 * s);
                        stg_put(wl, lr - 128 * wr, 32 * pr + 16 + 4 * q4, x2 * c + x1 * s);
                    }
                }
            }
            if (cb < 512) stg_flush(wl, qn + ((size_t)row0 + 128 * wr) * 512 + cb, 512, lane);
            else stg_flush(wl, qpe + ((size_t)row0 + 128 * wr) * 256 + (cb - 512), 256, lane);
        }
    }
    for (int v = N_Q + blockIdx.x; v < N_Q + N_KV; v += gridDim.x) {
        __syncthreads();
        {
            const int u = v - N_Q, mt = u >> 2, nt = u & 3, row0 = mt * 256, col0 = nt * 256;
            row_rinv256(ckv + (size_t)row0 * 128, 128, 128, s_rinv);
            f32x4 acc[8][4];
            gemm_main<true>(ckv + (size_t)row0 * 128, 128, wkv + (size_t)col0 * 128, 128, 128, smem, acc);
            const int cb = col0 + 64 * wc;
#pragma unroll
            for (int m = 0; m < 8; ++m) {
                const int lr = 128 * wr + 16 * m + (lane & 15), t = row0 + lr;
                const float r = s_rinv[lr];
                if (cb < 512) {
#pragma unroll
                    for (int n = 0; n < 4; ++n) stg_put(wl, lr - 128 * wr, 16 * n + 4 * q4, acc[m][n] * r);
                } else {
                    const int h = (cb - 512) >> 6, b = t >> 12, s = t & 4095;
                    bf16_t* dst = vbT + ((size_t)(b * 8 + h) * 64 + 4 * q4) * SEQ + s;
#pragma unroll
                    for (int n = 0; n < 4; ++n)
#pragma unroll
                        for (int i = 0; i < 4; ++i) dst[(size_t)(16 * n + i) * SEQ] = f2bf(acc[m][n][i] * r);
                }
            }
            if (cb < 512) stg_flush(wl, kn + ((size_t)row0 + 128 * wr) * 512 + cb, 512, lane);
        }
    }
    for (int v = N_Q + N_KV + (int)((blockIdx.x + (gridDim.x >> 1)) % gridDim.x); v < N_Q + N_KV + N_KM; v += gridDim.x) {
        {
            const int u = v - N_Q - N_KV, b = u >> 4, blk = u & 15;
            if (tid < 256) {
                const unsigned* src = (const unsigned*)(ka + ((size_t)b * SEQ + blk * 256) * 512) + tid;
                float s0 = 0.f, s1 = 0.f;
                for (int rr = 0; rr < 256; ++rr) { const unsigned w = src[(size_t)rr * 256]; s0 += bf_lo(w); s1 += bf_hi(w); }
                const int c = 2 * tid, h = c >> 6, d = c & 63;
                float* dst = kmean + ((size_t)((b * 8 + h) * 16 + blk)) * 64 + d;
                dst[0] = s0 * (1.0f / 256.0f); dst[1] = s1 * (1.0f / 256.0f);
            }
        }
    }
}

constexpr int NSUB = 4, KVT = 32 * NSUB;
constexpr int VSTR = KVT + 4;
constexpr int ATT_V_OFF = 2 * KVT * 104 * 2;
constexpr int ATT_ITEM_OFF = ATT_V_OFF + 2 * 64 * VSTR * 2;
template <bool MOBA>
DI void attn_item(const Params& P, int bh, int qt, char* smem) {
    constexpr int DK = MOBA ? 64 : 96, KS = DK / 16, KSTR = DK + 8;
    char* ws = P.ws;
    bf16_t* Ks = (bf16_t*)smem; bf16_t* Vs = (bf16_t*)(smem + ATT_V_OFF);
    const int tid = tid_fresh(), lane = tid & 63, w = __builtin_amdgcn_readfirstlane(tid >> 6), ql = lane & 31, hh = lane >> 5;
    const int b = bh >> 3, h = bh & 7, s0 = qt * 256, sq = s0 + 32 * w + ql;
    const size_t tq = (size_t)b * SEQ + sq;
    const bf16_t* Kg = (const bf16_t*)(ws + (MOBA ? OFF_KA : OFF_KN));
    const bf16_t* kpe = (const bf16_t*)(ws + OFF_KPE);
    const bf16_t* vT = (const bf16_t*)(ws + (MOBA ? OFF_VAT : OFF_VBT)) + (size_t)bh * 64 * SEQ;
    bf16x8 qf[KS];
    if (MOBA) {
        const bf16_t* qa = (const bf16_t*)(ws + OFF_QA) + tq * 512 + h * 64 + 8 * hh;
#pragma unroll
        for (int ks = 0; ks < 4; ++ks) qf[ks] = *(const bf16x8*)(qa + 16 * ks);
    } else {
        const bf16_t* qn = (const bf16_t*)(ws + OFF_QN) + tq * 512 + h * 64 + 8 * hh;
        const bf16_t* qp = (const bf16_t*)(ws + OFF_QPE) + tq * 256 + h * 32 + 8 * hh;
#pragma unroll
        for (int ks = 0; ks < 4; ++ks) qf[ks] = *(const bf16x8*)(qn + 16 * ks);
#pragma unroll
        for (int ks = 4; ks < KS; ++ks) qf[ks] = *(const bf16x8*)(qp + 16 * (ks - 4));
    }
    unsigned selmask = 0xffffffffu;
    if (MOBA) {
        const int blk = qt;
        float qv[32];
#pragma unroll
        for (int ks = 0; ks < 4; ++ks) {
            const u32x4 wq = __builtin_bit_cast(u32x4, qf[ks]);
#pragma unroll
            for (int j = 0; j < 4; ++j) { qv[8 * ks + 2 * j] = bf_lo(wq[j]); qv[8 * ks + 2 * j + 1] = bf_hi(wq[j]); }
        }
        const float* km = (const float*)(ws + OFF_KMEAN) + (size_t)bh * 16 * 64 + 8 * hh;
        float g[16];
#pragma unroll
        for (int n = 0; n < 16; ++n) {
            float a = -INFINITY;
            if (n < blk) {
                a = 0.f;
#pragma unroll
                for (int ks = 0; ks < 4; ++ks) {
                    const f32x4 k0 = *(const f32x4*)(km + n * 64 + 16 * ks), k1 = *(const f32x4*)(km + n * 64 + 16 * ks + 4);
#pragma unroll
                    for (int j = 0; j < 4; ++j) { a += qv[8 * ks + j] * k0[j]; a += qv[8 * ks + 4 + j] * k1[j]; }
                }
                a += __shfl_xor(a, 32);
            }
            g[n] = a;
        }
        unsigned mask = 0u;
        if (blk <= 3) mask = (1u << blk) - 1u;
        else {
#pragma unroll
            for (int r = 0; r < 3; ++r) {
                float best = -INFINITY; int bi = 0;
#pragma unroll
                for (int n = 0; n < 16; ++n) if (g[n] > best) { best = g[n]; bi = n; }
                mask |= 1u << bi;
#pragma unroll
                for (int n = 0; n < 16; ++n) g[n] = (n == bi) ? -INFINITY : g[n];
            }
        }
        selmask = mask | (1u << blk);
    }
    const int krow = tid >> 3, kch = tid & 7;
    const int vd = tid >> 4, vch = tid & 15;
    const bf16_t* kp0 = Kg + ((size_t)b * SEQ + krow) * 512 + h * 64 + kch * 8;
    const bf16_t* kpp = kpe + ((size_t)b * SEQ + (tid >> 2)) * 32 + (tid & 3) * 8;
    const bf16_t* vp0 = vT + (size_t)vd * SEQ + vch * 8;
    u32x4 rk[3], rv[2];
    const int nkt = 2 * qt + 2;
#define ATT_GLOAD(kt) do { \
        rk[0] = *(const u32x4*)(kp0 + (size_t)(KVT * (kt)) * 512); rk[1] = *(const u32x4*)(kp0 + (size_t)(KVT * (kt) + 64) * 512); \
        if (!MOBA) rk[2] = *(const u32x4*)(kpp + (size_t)(KVT * (kt)) * 32); \
        rv[0] = *(const u32x4*)(vp0 + KVT * (kt)); rv[1] = *(const u32x4*)(vp0 + (size_t)32 * SEQ + KVT * (kt)); } while (0)
    ATT_GLOAD(0);
    f32x16 O[2];
#pragma unroll
    for (int i = 0; i < 16; ++i) { O[0][i] = 0.f; O[1][i] = 0.f; }
    float mrun = -INFINITY, lrun = 0.f;
    const int wq0 = s0 + 32 * w;
    for (int kt = 0; kt < nkt; ++kt) {
        bf16_t* Kb = Ks + (kt & 1) * KVT * KSTR; bf16_t* Vb = Vs + (kt & 1) * 64 * VSTR;
        *(u32x4*)(Kb + krow * KSTR + kch * 8) = rk[0];
        *(u32x4*)(Kb + (krow + 64) * KSTR + kch * 8) = rk[1];
        if (!MOBA) *(u32x4*)(Kb + (tid >> 2) * KSTR + 64 + (tid & 3) * 8) = rk[2];
        *(u32x2*)(Vb + vd * VSTR + vch * 8) = (u32x2){rv[0][0], rv[0][1]};
        *(u32x2*)(Vb + vd * VSTR + vch * 8 + 4) = (u32x2){rv[0][2], rv[0][3]};
        *(u32x2*)(Vb + (vd + 32) * VSTR + vch * 8) = (u32x2){rv[1][0], rv[1][1]};
        *(u32x2*)(Vb + (vd + 32) * VSTR + vch * 8 + 4) = (u32x2){rv[1][2], rv[1][3]};
        __syncthreads();
        if (kt + 1 < nkt) ATT_GLOAD(kt + 1);
        const int kbase = KVT * kt;
        if (kbase <= wq0 + 31) {
            f32x16 Sv[NSUB];
#pragma unroll
            for (int sub = 0; sub < NSUB; ++sub) {
#pragma unroll
                for (int i = 0; i < 16; ++i) Sv[sub][i] = 0.f;
#pragma unroll
                for (int ks = 0; ks < KS; ++ks) {
                    const bf16x8 kf = *(const bf16x8*)(Kb + (32 * sub + ql) * KSTR + 16 * ks + 8 * hh);
                    Sv[sub] = MFMA32(kf, qf[ks], Sv[sub]);
                }
            }
            if (kbase + KVT - 1 > wq0) {
#pragma unroll
                for (int sub = 0; sub < NSUB; ++sub) {
                    const int thr = sq - kbase - 32 * sub - 4 * hh;
#pragma unroll
                    for (int i = 0; i < 16; ++i) if (((i & 3) + 8 * (i >> 2)) > thr) Sv[sub][i] = -INFINITY;
                }
            }
            float mt = -INFINITY;
#pragma unroll
            for (int i = 0; i < 16; ++i) mt = fmaxf(fmaxf(mt, fmaxf(Sv[0][i], Sv[1][i])), fmaxf(Sv[2][i], Sv[3][i]));
            mt = fmaxf(mt, __shfl_xor(mt, 32));
            bool sel = true;
            if (MOBA) { sel = (selmask >> (kbase >> 8)) & 1u; if (!sel) mt = -INFINITY; }
            const bool need = mt > mrun + 8.0f;
            if (__builtin_amdgcn_ballot_w64(need) != 0ull) {
                const float mnew = fmaxf(mrun, mt);
                const float ms = (mnew == -INFINITY) ? 0.f : mnew;
                const float alpha = __builtin_amdgcn_exp2f(mrun - ms);
                lrun *= alpha; mrun = mnew;
#pragma unroll
                for (int i = 0; i < 16; ++i) { O[0][i] *= alpha; O[1][i] *= alpha; }
            }
            const float msafe = (mrun == -INFINITY) ? 0.f : mrun;
            const float msub = sel ? msafe : INFINITY;
            float psum = 0.f;
#pragma unroll
            for (int sub = 0; sub < NSUB; ++sub)
#pragma unroll
                for (int i = 0; i < 16; ++i) { const float pv = __builtin_amdgcn_exp2f(Sv[sub][i] - msub); Sv[sub][i] = pv; psum += pv; }
            lrun += psum;
#pragma unroll
            for (int sub = 0; sub < NSUB; ++sub)
#pragma unroll
                for (int s = 0; s < 2; ++s) {
                    u32x4 pw;
#pragma unroll
                    for (int j = 0; j < 4; ++j) pw[j] = pk_bf16(Sv[sub][8 * s + 2 * j], Sv[sub][8 * s + 2 * j + 1]);
                    const bf16x8 pf = __builtin_bit_cast(bf16x8, pw);
#pragma unroll
                    for (int dt = 0; dt < 2; ++dt) {
                        const bf16_t* vrow = Vb + (32 * dt + ql) * VSTR + 32 * sub + 16 * s + 4 * hh;
                        const u32x2 v0 = *(const u32x2*)vrow, v1 = *(const u32x2*)(vrow + 8);
                        const bf16x8 vf = __builtin_bit_cast(bf16x8, (u32x4){v0[0], v0[1], v1[0], v1[1]});
                        O[dt] = MFMA32(vf, pf, O[dt]);
                    }
                }
        }
    }
#undef ATT_GLOAD
    lrun += __shfl_xor(lrun, 32);
    const float inv = 1.0f / lrun;
    bf16_t* y = (bf16_t*)(ws + (MOBA ? OFF_YA : OFF_YB)) + tq * 512 + h * 64 + 4 * hh;
#pragma unroll
    for (int dt = 0; dt < 2; ++dt)
#pragma unroll
        for (int g = 0; g < 4; ++g)
            *(u32x2*)(y + 32 * dt + 8 * g) = (u32x2){pk_bf16(O[dt][4 * g] * inv, O[dt][4 * g + 1] * inv), pk_bf16(O[dt][4 * g + 2] * inv, O[dt][4 * g + 3] * inv)};
}

DI void phase_attn(const Params& P, char* smem, int ci = 0) {
    unsigned* ctr = (unsigned*)(P.ws + OFF_CTR) + ci;
    int* s_item = (int*)(smem + ATT_ITEM_OFF);
    for (;;) {
        __syncthreads();
        if (threadIdx.x == 0) *s_item = (int)atomicAdd(ctr, 1u);
        __syncthreads();
        const int item = *s_item;
        if (item >= 2048) break;
        const int qt = 15 - (item >> 7), rest = item & 127, bh = rest & 63;
        if (rest < 64) attn_item<false>(P, bh, qt, smem); else attn_item<true>(P, bh, qt, smem);
    }
}

DI void phase_merge(const Params& P, char* smem, const BlkMap& bm) {
    char* ws = P.ws;
    const bf16_t* ya = (const bf16_t*)(ws + OFF_YA); const bf16_t* yb = (const bf16_t*)(ws + OFF_YB);
    const bf16_t* wa = (const bf16_t*)(ws + OFF_WTA); const bf16_t* wb = (const bf16_t*)(ws + OFF_WTB);
    const bf16_t* ga = (const bf16_t*)(ws + OFF_GA); const bf16_t* gb = (const bf16_t*)(ws + OFF_GB);
    bf16_t* merged = (bf16_t*)(ws + OFF_MERGED);
    const int tid = tid_fresh(), lane = tid & 63, wid = __builtin_amdgcn_readfirstlane(tid >> 6), wr = wid >> 2, wc = wid & 3, q4 = lane >> 4;
    char* wl = smem + wid * WST_BYTES;
    constexpr int Mt = T / 256, Nt = 4;
    for (int v = tile_first(bm); v < tile_count(bm, Mt, Nt); v += tile_step(bm)) {
        int mt, nt; tile_map(bm, v, Mt, Nt, mt, nt);
        const int row0 = mt * 256, col0 = nt * 256;
        f32x4 acc[8][4];
        gemm_main<true>(ya + (size_t)row0 * 512, 512, wa + (size_t)col0 * 512, 512, 512, smem, acc);
#pragma unroll
        for (int m = 0; m < 8; ++m) {
            const size_t t = row0 + 128 * wr + 16 * m + (lane & 15);
#pragma unroll
            for (int n = 0; n < 4; ++n) {
                const int c = col0 + 64 * wc + 16 * n + 4 * q4;
                const u32x2 wa2 = *(const u32x2*)(ga + t * 1024 + c), wb2 = *(const u32x2*)(gb + t * 1024 + c);
                acc[m][n][0] *= bf_lo(wa2[0]) / fmaxf(bf_lo(wb2[0]), 1e-30f);
                acc[m][n][1] *= bf_hi(wa2[0]) / fmaxf(bf_hi(wb2[0]), 1e-30f);
                acc[m][n][2] *= bf_lo(wa2[1]) / fmaxf(bf_lo(wb2[1]), 1e-30f);
                acc[m][n][3] *= bf_hi(wa2[1]) / fmaxf(bf_hi(wb2[1]), 1e-30f);
            }
        }
        gemm_main<false>(yb + (size_t)row0 * 512, 512, wb + (size_t)col0 * 512, 512, 512, smem, acc);
#pragma unroll
        for (int m = 0; m < 8; ++m) {
            const size_t t = row0 + 128 * wr + 16 * m + (lane & 15);
#pragma unroll
            for (int n = 0; n < 4; ++n) {
                const int c = col0 + 64 * wc + 16 * n + 4 * q4;
                const u32x2 wb2 = *(const u32x2*)(gb + t * 1024 + c);
                f32x4 o;
                o[0] = fmaxf(bf_lo(wb2[0]), 1e-30f) * acc[m][n][0]; o[1] = fmaxf(bf_hi(wb2[0]), 1e-30f) * acc[m][n][1];
                o[2] = fmaxf(bf_lo(wb2[1]), 1e-30f) * acc[m][n][2]; o[3] = fmaxf(bf_hi(wb2[1]), 1e-30f) * acc[m][n][3];
                stg_put(wl, 16 * m + (lane & 15), 16 * n + 4 * q4, o);
            }
        }
        stg_flush(wl, merged + ((size_t)row0 + 128 * wr) * 1024 + col0 + 64 * wc, 1024, lane);
    }
}

DI void phase_outproj(const Params& P, char* smem, const BlkMap& bm) {
    char* ws = P.ws;
    const bf16_t* merged = (const bf16_t*)(ws + OFF_MERGED); const bf16_t* wo = (const bf16_t*)(ws + OFF_WTOUT);
    float* x2 = (float*)(ws + OFF_X2); bf16_t* x2b = (bf16_t*)(ws + OFF_X2B); float* ssq2 = (float*)(ws + OFF_SSQ2);
    const int tid = tid_fresh(), lane = tid & 63, wid = __builtin_amdgcn_readfirstlane(tid >> 6), wr = wid >> 2, wc = wid & 3, q4 = lane >> 4;
    char* wl = smem + wid * WST_BYTES;
    constexpr int Mt = T / 256, Nt = 4;
    for (int v = tile_first(bm); v < tile_count(bm, Mt, Nt); v += tile_step(bm)) {
        int mt, nt; tile_map(bm, v, Mt, Nt, mt, nt);
        const int row0 = mt * 256, col0 = nt * 256;
        f32x4 acc[8][4];
        gemm_main<true>(merged + (size_t)row0 * 1024, 1024, wo + (size_t)col0 * 1024, 1024, 1024, smem, acc);
#pragma unroll
        for (int m = 0; m < 8; ++m) {
            const size_t t = row0 + 128 * wr + 16 * m + (lane & 15);
            float ssp = 0.f;
#pragma unroll
            for (int n = 0; n < 4; ++n) {
                const int c = col0 + 64 * wc + 16 * n + 4 * q4;
                const f32x4 o = *(const f32x4*)(P.x + t * 1024 + c) + acc[m][n];
                *(f32x4*)(x2 + t * 1024 + c) = o;
                stg_put(wl, 16 * m + (lane & 15), 16 * n + 4 * q4, o);
                ssp += o[0] * o[0] + o[1] * o[1] + o[2] * o[2] + o[3] * o[3];
            }
            ssp += __shfl_xor(ssp, 16); ssp += __shfl_xor(ssp, 32);
            if (q4 == 0) atomicAdd(ssq2 + t, ssp);
        }
        stg_flush(wl, x2b + ((size_t)row0 + 128 * wr) * 1024 + col0 + 64 * wc, 1024, lane);
    }
}

DI int mono(int b) { return b ^ ((b >> 31) & 0x7fffffff); }
DI void ins16(int (&a)[16], int v) {
#pragma unroll
    for (int s = 0; s < 16; ++s) { const int t = max(a[s], v); v = min(a[s], v); a[s] = t; }
}
DI void cex(int& hi, int& lo) { const int a = max(hi, lo), b = min(hi, lo); hi = a; lo = b; }
DI void bitonic_merge16(int (&a)[16]) {
#pragma unroll
    for (int j = 8; j > 0; j >>= 1)
#pragma unroll
        for (int i = 0; i < 16; ++i) { const int l = i ^ j; if (l > i) cex(a[i], a[l]); }
}
DI void bitonic_sort16(int (&a)[16]) {
#pragma unroll
    for (int k = 2; k <= 16; k <<= 1)
#pragma unroll
        for (int j = k >> 1; j > 0; j >>= 1)
#pragma unroll
            for (int i = 0; i < 16; ++i) { const int l = i ^ j; if (l > i) { if ((i & k) == 0) cex(a[i], a[l]); else cex(a[l], a[i]); } }
}
DI void merge_top16(int (&x)[16], const int (&y)[16]) {
#pragma unroll
    for (int i = 0; i < 16; ++i) x[i] = max(x[i], y[15 - i]);
    bitonic_merge16(x);
}
DI float rinv2_of(const float* ssq2, size_t t) { return rsqrtf(ssq2[t] * (1.0f / DM) + RMS_EPS); }
DI void peer_topk_task(const Params& P, const bf16_t* qrow, size_t t, int h, unsigned* lw, int ql, int hh) {
    char* ws = P.ws;
    const bf16_t* keysb = (const bf16_t*)(ws + OFF_KEYS);
    int* pidx = (int*)(ws + OFF_PIDX); float* pg = (float*)(ws + OFF_PG);
    int a[2][16];
#pragma unroll
    for (int half = 0; half < 2; ++half) {
        bf16x8 qf[8];
#pragma unroll
        for (int ks = 0; ks < 8; ++ks) qf[ks] = *(const bf16x8*)(qrow + half * 128 + 16 * ks + 8 * hh);
        const bf16_t* kb = keysb + (size_t)((half * 8 + h) * 128) * 128 + 8 * hh;
#pragma unroll
        for (int nt = 0; nt < 4; ++nt) {
            f32x16 acc;
#pragma unroll
            for (int i = 0; i < 16; ++i) acc[i] = 0.f;
#pragma unroll
            for (int ks = 0; ks < 8; ++ks) {
                const bf16x8 kf = *(const bf16x8*)(kb + (size_t)(32 * nt + ql) * 128 + 16 * ks);
                acc = MFMA32(kf, qf[ks], acc);
            }
            int kk[16];
#pragma unroll
            for (int i = 0; i < 16; ++i) {
                const int n = 32 * nt + (i & 3) + 8 * (i >> 2) + 4 * hh;
                kk[i] = (mono(__float_as_int(acc[i])) & ~127) | (127 - n);
            }
            bitonic_sort16(kk);
            if (nt == 0) {
#pragma unroll
                for (int s = 0; s < 16; ++s) a[half][s] = kk[s];
            } else merge_top16(a[half], kk);
        }
        int pa[16];
#pragma unroll
        for (int s = 0; s < 16; ++s) pa[s] = __shfl_xor(a[half][s], 32);
        merge_top16(a[half], pa);
    }
    float f1[16], f2[16];
#pragma unroll
    for (int i = 0; i < 16; ++i) { f1[i] = __int_as_float(mono(a[0][i] & ~127)); f2[i] = __int_as_float(mono(a[1][i] & ~127)); }
#pragma unroll
    for (int k = 0; k < 4; ++k) {
        unsigned w1 = 0u, w2 = 0u;
#pragma unroll
        for (int j = 0; j < 4; ++j) { w1 |= (unsigned)(127 - (a[0][4 * k + j] & 127)) << (8 * j); w2 |= (unsigned)(127 - (a[1][4 * k + j] & 127)) << (8 * j); }
        lw[k] = w1; lw[4 + k] = w2;
    }
    int bb[16];
#pragma unroll
    for (int s = 0; s < 16; ++s) bb[s] = (int)0x80000000;
#pragma unroll
    for (int i = 0; i < 16; ++i)
#pragma unroll
        for (int j = 0; j < 16; ++j)
            if ((i + 1) * (j + 1) <= 16) {
                const float c = f1[i] + f2[j];
                const int key = (mono(__float_as_int(c)) & ~255) | (i << 4) | j;
                ins16(bb, key);
            }
    const float r2 = rinv2_of((const float*)(ws + OFF_SSQ2), t);
    float z[16], e[16], sum = 0.f;
#pragma unroll
    for (int r = 0; r < 16; ++r) z[r] = __int_as_float(mono(bb[r] & ~255)) * r2;
#pragma unroll
    for (int r = 0; r < 16; ++r) { e[r] = __expf(z[r] - z[0]); sum += e[r]; }
    const float inv = 1.0f / sum;
    if (hh == 0) {
        int id[16];
#pragma unroll
        for (int r = 0; r < 16; ++r) {
            const int cid = bb[r] & 255, i = cid >> 4, j = cid & 15;
            const unsigned w1 = lw[i >> 2], w2 = lw[4 + (j >> 2)];
            const int n1 = (w1 >> (8 * (i & 3))) & 255, n2 = (w2 >> (8 * (j & 3))) & 255;
            id[r] = n1 * 128 + n2;
        }
        int* di = pidx + t * 128 + h * 16; float* dg = pg + t * 128 + h * 16;
#pragma unroll
        for (int k = 0; k < 4; ++k) {
            *(u32x4*)(di + 4 * k) = (u32x4){(unsigned)id[4 * k], (unsigned)id[4 * k + 1], (unsigned)id[4 * k + 2], (unsigned)id[4 * k + 3]};
            *(f32x4*)(dg + 4 * k) = (f32x4){e[4 * k] * inv, e[4 * k + 1] * inv, e[4 * k + 2] * inv, e[4 * k + 3] * inv};
        }
    }
}

DI void phase_peerq(const Params& P, char* smem, const BlkMap& bm) {
    char* ws = P.ws;
    const int tid = tid_fresh(), lane = tid & 63, wid = __builtin_amdgcn_readfirstlane(tid >> 6), wr = wid >> 2, wc = wid & 3, q4 = lane >> 4;
    const int gw = blockIdx.x * NWV + wid, nw = gridDim.x * NWV;
    const int gt = blockIdx.x * NTHR + tid, ntd = gridDim.x * NTHR;
    {
        unsigned* ub = (unsigned*)(ws + OFF_UB); unsigned* vb = (unsigned*)(ws + OFF_VB8);
        for (int idx = gt; idx < 16384 * 1024 / 16; idx += ntd) {
            const size_t e = (size_t)idx * 16; const int c = (int)(e & 1023);
            u32x4 uo, vo;
#pragma unroll
            for (int q = 0; q < 4; ++q) {
                const f32x4 g0 = *(const f32x4*)(P.ffn_g + c + 4 * q) * U8_SCALE;
                const f32x4 u0 = *(const f32x4*)(P.eu + e + 4 * q) * g0;
                const f32x4 v0 = *(const f32x4*)(P.ev + e + 4 * q) * V8_SCALE;
                uo[q] = pack_fp8x4(u0[0], u0[1], u0[2], u0[3]);
                vo[q] = pack_fp8x4(v0[0], v0[1], v0[2], v0[3]);
            }
            *(u32x4*)(ub + e / 4) = uo;
            *(u32x4*)(vb + e / 4) = vo;
        }
    }
    const bf16_t* x2b = (const bf16_t*)(ws + OFF_X2B); const bf16_t* wp = (const bf16_t*)(ws + OFF_WTPQ);
    constexpr int QIMG_STR = 528, QIMG_BYTES = 256 * QIMG_STR;
    constexpr int Mt = T / 256, Nt = 8;
    for (int v = tile_first(bm); v < tile_count(bm, Mt, Nt); v += tile_step(bm)) {
        int mt, nt; tile_map(bm, v, Mt, Nt, mt, nt);
        const int row0 = mt * 256, col0 = nt * 256;
        f32x4 acc[8][4];
        gemm_main<true>(x2b + (size_t)row0 * 1024, 1024, wp + (size_t)col0 * 1024, 1024, 1024, smem, acc);
        int lz = lane; asm volatile("" : "+v"(lz));
#pragma unroll
        for (int m = 0; m < 8; ++m) {
#pragma unroll
            for (int n = 0; n < 4; ++n) {
                const f32x4 v4 = acc[m][n];
                *(u32x2*)(smem + (128 * wr + 16 * m + (lz & 15)) * QIMG_STR + (64 * wc + 16 * n + 4 * (lz >> 4)) * 2) = (u32x2){pk_bf16(v4[0], v4[1]), pk_bf16(v4[2], v4[3])};
            }
        }
        __syncthreads();
        peer_topk_task(P, (const bf16_t*)(smem + (32 * wid + (lz & 31)) * QIMG_STR), (size_t)row0 + 32 * wid + (lz & 31), nt,
                       (unsigned*)(smem + QIMG_BYTES) + wid * 512 + lz * 8, lz & 31, lz >> 5);
    }
}

DI float reduce16(float (&p)[16], int lane) {
    const bool b5 = lane & 32, b4 = lane & 16, b3 = lane & 8, b2 = lane & 4;
    float r8[8], r4[4], r2[2];
#pragma unroll
    for (int i = 0; i < 8; ++i) { const float keep = b5 ? p[i + 8] : p[i], send = b5 ? p[i] : p[i + 8]; r8[i] = keep + __shfl_xor(send, 32); }
#pragma unroll
    for (int i = 0; i < 4; ++i) { const float keep = b4 ? r8[i + 4] : r8[i], send = b4 ? r8[i] : r8[i + 4]; r4[i] = keep + __shfl_xor(send, 16); }
#pragma unroll
    for (int i = 0; i < 2; ++i) { const float keep = b3 ? r4[i + 2] : r4[i], send = b3 ? r4[i] : r4[i + 2]; r2[i] = keep + __shfl_xor(send, 8); }
    const float keep = b2 ? r2[1] : r2[0], send = b2 ? r2[0] : r2[1];
    float r1 = keep + __shfl_xor(send, 4);
    r1 += __shfl_xor(r1, 2); r1 += __shfl_xor(r1, 1);
    return r1;
}
constexpr size_t OFF_PART = R1;
constexpr size_t OFF_SSQ = OFF_COSA;
DI bool slice_next(const BlkMap& bm, int it, int wid, int& t, int& x) {
    if (bm.ok) { t = bm.rank * NWV + wid + it * (32 * NWV); x = bm.xcd; return t < T; }
    const int p = (int)blockIdx.x * NWV + wid + it * (int)gridDim.x * NWV; t = p >> 3; x = p & 7; return p < T * 8;
}
DI void phase_exp_u(const Params& P, const BlkMap& bm) {
    char* ws = P.ws;
    const bf16_t* x2b = (const bf16_t*)(ws + OFF_X2B);
    const unsigned char* ub = (const unsigned char*)(ws + OFF_UB);
    const int* pidx = (const int*)(ws + OFF_PIDX);
    float* part = (float*)(ws + OFF_PART);
    const int tid = tid_fresh(), lane = tid & 63, wid = __builtin_amdgcn_readfirstlane(tid >> 6), g = lane >> 3, r = lane & 7;
    int t, x;
    for (int it = 0; slice_next(bm, it, wid, t, x); ++it) {
        f32x2 xv[8];
        {
            const bf16_t* xp = x2b + (size_t)t * 1024 + 128 * x + 16 * r;
            const u32x4 a = *(const u32x4*)xp, b = *(const u32x4*)(xp + 8);
#pragma unroll
            for (int j = 0; j < 4; ++j) { xv[j] = (f32x2){bf_lo(a[j]), bf_hi(a[j])}; xv[4 + j] = (f32x2){bf_lo(b[j]), bf_hi(b[j])}; }
        }
        int id[16];
#pragma unroll
        for (int q = 0; q < 4; ++q) { const u32x4 w = *(const u32x4*)(pidx + (size_t)t * 128 + g * 16 + 4 * q); id[4 * q] = (int)w[0]; id[4 * q + 1] = (int)w[1]; id[4 * q + 2] = (int)w[2]; id[4 * q + 3] = (int)w[3]; }
        u32x4 uu[16];
        const unsigned char* ubase = ub + 128 * x + 16 * r;
#pragma unroll
        for (int j = 0; j < 16; ++j) uu[j] = *(const u32x4*)(ubase + (size_t)id[j] * 1024);
        float p[16];
#pragma unroll
        for (int j = 0; j < 16; ++j) {
            f32x2 acc = {0.f, 0.f};
#pragma unroll
            for (int q = 0; q < 4; ++q) { acc = __builtin_elementwise_fma(fp8lo(uu[j][q]), xv[2 * q], acc); acc = __builtin_elementwise_fma(fp8hi(uu[j][q]), xv[2 * q + 1], acc); }
            p[j] = acc.x + acc.y;
        }
        const bool b4 = r & 4, b2 = r & 2, b1 = r & 1;
        float q8[8], q4v[4], q2[2];
#pragma unroll
        for (int i = 0; i < 8; ++i) { const float keep = b4 ? p[i + 8] : p[i], send = b4 ? p[i] : p[i + 8]; q8[i] = keep + __shfl_xor(send, 4); }
#pragma unroll
        for (int i = 0; i < 4; ++i) { const float keep = b2 ? q8[i + 4] : q8[i], send = b2 ? q8[i] : q8[i + 4]; q4v[i] = keep + dpp_get<0x4E>(send); }
#pragma unroll
        for (int i = 0; i < 2; ++i) { const float keep = b1 ? q4v[i + 2] : q4v[i], send = b1 ? q4v[i] : q4v[i + 2]; q2[i] = keep + dpp_get<0xB1>(send); }
        *(f32x2*)(part + ((size_t)x * T + t) * 128 + 2 * lane) = (f32x2){q2[0], q2[1]};
    }
}
DI void phase_exp_w(const Params& P) {
    char* ws = P.ws;
    const float* ssq2 = (const float*)(ws + OFF_SSQ2);
    float* pg = (float*)(ws + OFF_PG); const unsigned* pidx = (const unsigned*)(ws + OFF_PIDX);
    const float* part = (const float*)(ws + OFF_PART);
    const int tid = tid_fresh(), lane = tid & 63, wid = __builtin_amdgcn_readfirstlane(tid >> 6);
    const int gw = blockIdx.x * NWV + wid, nw = gridDim.x * NWV;
    for (int t = gw; t < T; t += nw) {
        f32x2 tot = {0.f, 0.f};
#pragma unroll
        for (int xx = 0; xx < 8; ++xx) tot += *(const f32x2*)(part + ((size_t)xx * T + t) * 128 + 2 * lane);
        const float r2 = rinv2_of(ssq2, t) * (1.0f / U8_SCALE);
        const f32x2 gg = *(const f32x2*)(pg + (size_t)t * 128 + 2 * lane);
        const float a0 = tot.x * r2, a1 = tot.y * r2;
        const float w0 = gg.x * 0.5f * a0 * (1.0f + erff(a0 * 0.70710678118654752f)) * (1.0f / V8_SCALE);
        const float w1 = gg.y * 0.5f * a1 * (1.0f + erff(a1 * 0.70710678118654752f)) * (1.0f / V8_SCALE);
        const u32x2 ids = *(const u32x2*)(pidx + (size_t)t * 128 + 2 * lane);
        *(u32x2*)(pg + (size_t)t * 128 + 2 * lane) = (u32x2){(ids[0] << 16) | (unsigned)f2bf(w0), (ids[1] << 16) | (unsigned)f2bf(w1)};
    }
}
DI void phase_exp_v(const Params& P, const BlkMap& bm, char* smem) {
    char* ws = P.ws;
    const float* x2 = (const float*)(ws + OFF_X2);
    const unsigned char* vb = (const unsigned char*)(ws + OFF_VB8);
    const float* rinv2 = (const float*)(ws + OFF_RINV2);
    const int* pidx = (const int*)(ws + OFF_PIDX); const float* pg = (const float*)(ws + OFF_PG);
    const float* part = (const float*)(ws + OFF_PART);
    float* ssq = (float*)(ws + OFF_SSQ);
    const int tid = tid_fresh(), lane = tid & 63, wid = __builtin_amdgcn_readfirstlane(tid >> 6), g = lane >> 3, r = lane & 7;
    int t, x;
    for (int it = 0; slice_next(bm, it, wid, t, x); ++it) {
        int id[16]; float wj[16];
#pragma unroll
        for (int q = 0; q < 4; ++q) {
            const u32x4 w = *(const u32x4*)((const unsigned*)pg + (size_t)t * 128 + g * 16 + 4 * q);
#pragma unroll
            for (int c = 0; c < 4; ++c) { id[4 * q + c] = (int)(w[c] >> 16); wj[4 * q + c] = __uint_as_float(w[c] << 16); }
        }
        u32x4 vv[16];
        const unsigned char* vbase = vb + 128 * x + 16 * r;
#pragma unroll
        for (int j = 0; j < 16; ++j) vv[j] = *(const u32x4*)(vbase + (size_t)id[j] * 1024);
        f32x2 out[8];
#pragma unroll
        for (int i = 0; i < 8; ++i) out[i] = (f32x2){0.f, 0.f};
#pragma unroll
        for (int j = 0; j < 16; ++j) {
            const f32x2 w2 = {wj[j], wj[j]};
#pragma unroll
            for (int q = 0; q < 4; ++q) { out[2 * q] = __builtin_elementwise_fma(fp8lo(vv[j][q]), w2, out[2 * q]); out[2 * q + 1] = __builtin_elementwise_fma(fp8hi(vv[j][q]), w2, out[2 * q + 1]); }
        }
        float o[16];
#pragma unroll
        for (int i = 0; i < 8; ++i) { o[2 * i] = out[i].x; o[2 * i + 1] = out[i].y; }
        const bool b5 = lane & 32, b4 = lane & 16, b3 = lane & 8;
        float q8[8], q4v[4], q2[2];
#pragma unroll
        for (int i = 0; i < 8; ++i) q8[i] = swap_add32(o[i], o[i + 8]);
#pragma unroll
        for (int i = 0; i < 4; ++i) q4v[i] = swap_add16(q8[i], q8[i + 4]);
#pragma unroll
        for (int i = 0; i < 2; ++i) { const float keep = b3 ? q4v[i + 2] : q4v[i], send = b3 ? q4v[i] : q4v[i + 2]; q2[i] = keep + dpp_get<0x128>(send); }
        const size_t col = (size_t)t * 1024 + 128 * x + 16 * r + 2 * g;
        const f32x2 xr = *(const f32x2*)(x2 + col);
        const float y0 = xr.x + q2[0], y1 = xr.y + q2[1];
        *(f32x2*)(P.out + col) = (f32x2){y0, y1};
    }
}
DI void phase_final_norm(const Params& P) {
    const int tid = tid_fresh(), lane = tid & 63, wid = __builtin_amdgcn_readfirstlane(tid >> 6);
    const int gw = blockIdx.x * NWV + wid, nw = gridDim.x * NWV;
    for (int t = gw; t < T; t += nw) {
        float* o = P.out + (size_t)t * 1024;
        f32x4 y[4]; float ss = 0.f;
#pragma unroll
        for (int i = 0; i < 4; ++i) { y[i] = *(const f32x4*)(o + 4 * (lane + 64 * i)); ss += y[i][0] * y[i][0] + y[i][1] * y[i][1] + y[i][2] * y[i][2] + y[i][3] * y[i][3]; }
        ss = wave_sum(ss);
        const float rinv = rsqrtf(ss * (1.0f / DM) + RMS_EPS);
#pragma unroll
        for (int i = 0; i < 4; ++i) { const int c = 4 * (lane + 64 * i); *(f32x4*)(o + c) = y[i] * rinv * *(const f32x4*)(P.fin_g + c); }
    }
}

#define XB_TMO      128
#define XB_XCNT(j)  (256  + 64 * (j))
#define XB_XSUB(j)  (1280 + 64 * (j))
#define XB_XGEN(j)  (2304 + 64 * (j))
#define XB_TOP      3328
#define XB_TOPGEN   3392
#define XCD_BAR_WORDS 3456
#define XB_SPIN_CAP (1u << 18)
#define LAS __attribute__((address_space(3)))
DI unsigned xb_ld(unsigned* p)              { return __hip_atomic_load(p, __ATOMIC_RELAXED, __HIP_MEMORY_SCOPE_AGENT); }
DI unsigned xb_add(unsigned* p, unsigned v) { return __hip_atomic_fetch_add(p, v, __ATOMIC_RELAXED, __HIP_MEMORY_SCOPE_AGENT); }
#define XB_SPIN(cond, bar) do { unsigned _sp = 0; while (cond) { __builtin_amdgcn_s_sleep(1); \
    if ((++_sp & 255u) == 0u) { if (xb_ld(&(bar)[XB_TMO])) break; if (_sp > XB_SPIN_CAP) { atomicAdd(&(bar)[XB_TMO], 1u); break; } } } } while (0)
struct XcdBarrier { unsigned* bar; unsigned x; volatile LAS unsigned* st; };
DI XcdBarrier xcd_barrier_post(unsigned* bar, volatile LAS unsigned* st) {
    XcdBarrier b; b.bar = bar; b.x = (unsigned)__builtin_amdgcn_s_getreg((3 << 11) | 20) & 0xFu; b.st = st;
    if (threadIdx.x == 0) (void)xb_add(&bar[XB_XCNT(b.x)], 1u);
    return b;
}
DI void xcd_barrier_complete(unsigned* bar, unsigned x, unsigned& nloc, unsigned& nx) {
    const unsigned G = gridDim.x * gridDim.y * gridDim.z;
    unsigned sum, cnt, mine, sp = 0u;
    for (;;) {
        sum = 0u; cnt = 0u; mine = 0u;
#pragma unroll
        for (unsigned j = 0; j < 16; ++j) { const unsigned c = xb_ld(&bar[XB_XCNT(j)]); sum += c; cnt += (c > 0u) ? 1u : 0u; mine = (j == x) ? c : mine; }
        if (sum == G) break;
        __builtin_amdgcn_s_sleep(1);
        if ((++sp & 255u) == 0u) { if (xb_ld(&bar[XB_TMO])) break; if (sp > XB_SPIN_CAP) { atomicAdd(&bar[XB_TMO], 1u); break; } }
    }
    nloc = mine > 0u ? mine : 1u; nx = cnt > 0u ? cnt : 1u;
}
DI void xcd_barrier(const XcdBarrier& b) {
    asm volatile("s_waitcnt vmcnt(0)" ::: "memory");
    __syncthreads();
    if (threadIdx.x == 0) {
        unsigned* bar = b.bar;
        __builtin_amdgcn_s_waitcnt(0);
        unsigned nloc = b.st[0], nx = b.st[1];
        if (nloc == 0u) { xcd_barrier_complete(bar, b.x, nloc, nx); b.st[0] = nloc; b.st[1] = nx; }
        const unsigned old = xb_add(&bar[XB_XSUB(b.x)], 1u);
        const unsigned gen = old / nloc;
        if (old + 1u == (gen + 1u) * nloc) {
            __builtin_amdgcn_fence(__ATOMIC_RELEASE, "agent");
            asm volatile("s_waitcnt vmcnt(0)" ::: "memory");
            const unsigned og = xb_add(&bar[XB_TOP], 1u);
            const unsigned tg = og / nx;
            if (og + 1u == (tg + 1u) * nx) xb_add(&bar[XB_TOPGEN], 1u);
            else XB_SPIN(xb_ld(&bar[XB_TOPGEN]) == tg, bar);
            __builtin_amdgcn_fence(__ATOMIC_ACQUIRE, "agent");
            xb_add(&bar[XB_XGEN(b.x)], 1u);
            asm volatile("s_waitcnt vmcnt(0)" ::: "memory");
        } else {
            XB_SPIN(xb_ld(&bar[XB_XGEN(b.x)]) == gen, bar);
            __builtin_amdgcn_fence(__ATOMIC_ACQUIRE, "agent");
            asm volatile("s_waitcnt vmcnt(0)" ::: "memory");
        }
    }
    __syncthreads();
}

constexpr int SMEM_BYTES = 152 * 1024;
constexpr int XB_ST_OFF = 150 * 1024;
template <bool COOP>
__global__ void __launch_bounds__(512) hybrid_fwd(Params P, int ph_lo, int ph_hi) {
    extern __shared__ __attribute__((aligned(16))) char smem[];
#ifndef PROBE_REP
#define PROBE_REP 0
#endif
    volatile LAS unsigned* xst = (volatile LAS unsigned*)(smem + XB_ST_OFF);
    if (threadIdx.x == 0) { xst[0] = 0u; xst[1] = 0u; xst[2] = 0u; xst[3] = 0u; }
    __syncthreads();
    XcdBarrier xb; xb.bar = (unsigned*)(P.ws + OFF_CTR) + 256; xb.x = 0u; xb.st = xst;
    if (COOP) xb = xcd_barrier_post((unsigned*)(P.ws + OFF_CTR) + 256, xst);
    BlkMap bm; bm.xcd = 0; bm.rank = 0; bm.cnt = 1; bm.ok = 0;
    unsigned* census = (unsigned*)(P.ws + OFF_CTR) + 16;
    if (COOP) {
        bm.xcd = (int)xcc_id() & 7;
        if (threadIdx.x == 0) *(int*)smem = (int)atomicAdd(census + bm.xcd, 1u);
        __syncthreads();
        bm.rank = __builtin_amdgcn_readfirstlane(*(int*)smem);
        __syncthreads();
    }
#define RUN_PHASE(k, call) do { if (COOP || (ph_lo <= (k) && (k) <= ph_hi)) { if (COOP && (k) == 1) cg::this_grid().sync(); else if (COOP && (k) > 1) xcd_barrier(xb); \
        if (COOP && (k) == 1) { int okk = 1; const int per = (int)gridDim.x >> 3; for (int x_ = 0; x_ < 8; ++x_) okk &= ((int)census[x_] == per); \
            bm.cnt = per; bm.ok = okk && ((gridDim.x & 7) == 0) && per == 32; } \
        call; \
        if (COOP && ((PROBE_REP >> (k)) & 1)) { cg::this_grid().sync(); if ((k) == 3) phase_attn(P, smem, 1); else { call; } } } } while (0)
    RUN_PHASE(0, phase_prep(P));
    RUN_PHASE(1, phase_inproj(P, smem, bm));
    RUN_PHASE(2, phase_mla_up(P, smem));
    RUN_PHASE(3, phase_attn(P, smem));
    RUN_PHASE(4, phase_merge(P, smem, bm));
    RUN_PHASE(5, phase_outproj(P, smem, bm));
    RUN_PHASE(6, phase_peerq(P, smem, bm));
    RUN_PHASE(8, phase_exp_u(P, bm));
    RUN_PHASE(9, phase_exp_w(P));
    RUN_PHASE(10, phase_exp_v(P, bm, smem));
    RUN_PHASE(11, phase_final_norm(P));
#undef RUN_PHASE
}

extern "C" void kernel_launch(void* const* d_in, const int* in_sizes, int n_in, void* d_out, int out_size, void* d_ws, size_t ws_size, hipStream_t stream) {
    Params p{};
    p.x = (const float*)d_in[0]; p.pos = (const int*)d_in[1]; p.mix_g = (const float*)d_in[2]; p.w_in = (const float*)d_in[3];
    p.qn_g = (const float*)d_in[4]; p.w_qup = (const float*)d_in[5]; p.kvn_g = (const float*)d_in[6]; p.w_kvup = (const float*)d_in[7];
    p.w_a = (const float*)d_in[8]; p.w_b = (const float*)d_in[9]; p.w_out = (const float*)d_in[10]; p.ffn_g = (const float*)d_in[11];
    p.w_pq = (const float*)d_in[12]; p.keys1 = (const float*)d_in[13]; p.keys2 = (const float*)d_in[14]; p.eu = (const float*)d_in[15];
    p.ev = (const float*)d_in[16]; p.fin_g = (const float*)d_in[17];
    p.out = (float*)d_out; p.ws = (char*)d_ws;
    static int grid_blocks = 0;
    if (!grid_blocks) {
        int dev = 0, cus = 0, per_cu = 0;
        hipGetDevice(&dev);
        hipDeviceGetAttribute(&cus, hipDeviceAttributeMultiprocessorCount, dev);
#if MK_COOP
        hipFuncSetAttribute((const void*)hybrid_fwd<true>, hipFuncAttributeMaxDynamicSharedMemorySize, SMEM_BYTES);
        hipOccupancyMaxActiveBlocksPerMultiprocessor(&per_cu, hybrid_fwd<true>, NTHR, SMEM_BYTES);
#else
        hipFuncSetAttribute((const void*)hybrid_fwd<false>, hipFuncAttributeMaxDynamicSharedMemorySize, SMEM_BYTES);
        hipOccupancyMaxActiveBlocksPerMultiprocessor(&per_cu, hybrid_fwd<false>, NTHR, SMEM_BYTES);
#endif
        if (per_cu < 1) per_cu = 1;
        grid_blocks = cus * per_cu;
    }
#if MK_COOP
    hipMemsetAsync((char*)d_ws + OFF_CTR, 0, CTR_MEMSET_BYTES, stream);
    int lo = 0, hi = 11;
    void* args[] = {&p, &lo, &hi};
    hipError_t e = hipLaunchCooperativeKernel((void*)hybrid_fwd<true>, dim3(grid_blocks), dim3(NTHR), args, SMEM_BYTES, stream);
    if (e != hipSuccess) fprintf(stderr, "cooperative launch failed: %s (grid %d)\n", hipGetErrorString(e), grid_blocks);
#else
    hipMemsetAsync((char*)d_ws + OFF_CTR, 0, CTR_MEMSET_BYTES, stream);
    for (int ph = 0; ph <= 11; ++ph) hipLaunchKernelGGL(hybrid_fwd<false>, dim3(grid_blocks), dim3(NTHR), SMEM_BYTES, stream, p, ph, ph);
#endif
}
```

```cpp
#include <hip/hip_runtime.h>
#include <hip/hip_cooperative_groups.h>
#include <cstdio>
#include <cstdint>
namespace cg = cooperative_groups;

#ifndef MK_COOP
#define MK_COOP 1
#endif

typedef unsigned short bf16_t;
typedef short bf16x8 __attribute__((ext_vector_type(8)));
typedef float f32x4 __attribute__((ext_vector_type(4)));
typedef float f32x16 __attribute__((ext_vector_type(16)));
typedef unsigned u32x4 __attribute__((ext_vector_type(4)));
typedef unsigned u32x2 __attribute__((ext_vector_type(2)));
typedef __bf16 bf16x2_t __attribute__((ext_vector_type(2)));

#define DI __device__ __forceinline__

constexpr int T = 32768, SEQ = 4096, DM = 1024;
constexpr int NTHR = 512, NWV = 8;
constexpr int XB_LD = 1088;
constexpr float RMS_EPS = 1e-6f;
constexpr float LOG2E = 1.4426950408889634f;
constexpr float QS_A = 0.125f * LOG2E;
constexpr float QS_B = 0.10206207261596577f * LOG2E;

constexpr size_t MiB = 1ull << 20;
constexpr size_t OFF_WTIN = 0;
constexpr size_t OFF_WTQUP = 8 * MiB;
constexpr size_t OFF_WTKVUP = 8 * MiB + 512 * 1024;
constexpr size_t OFF_WTA = 9 * MiB;
constexpr size_t OFF_WTB = 10 * MiB;
constexpr size_t OFF_WTOUT = 11 * MiB;
constexpr size_t OFF_WTPQ = 13 * MiB;
constexpr size_t OFF_KEYS = 17 * MiB;
constexpr size_t OFF_COSA = 18 * MiB;
constexpr size_t OFF_SINA = 22 * MiB;
constexpr size_t OFF_COSB = 26 * MiB;
constexpr size_t OFF_SINB = 28 * MiB;
constexpr size_t OFF_RINV1 = 30 * MiB;
constexpr size_t OFF_RINV2 = 30 * MiB + 128 * 1024;
constexpr size_t OFF_KMEAN = 30 * MiB + 256 * 1024;
constexpr size_t OFF_CTR = 30 * MiB + 512 * 1024;
constexpr size_t OFF_SSQ2 = OFF_CTR + 32 * 1024;
constexpr size_t CTR_MEMSET_BYTES = 160 * 1024;
constexpr size_t R1 = 31 * MiB;
constexpr size_t OFF_XB = R1;
constexpr size_t OFF_QN = R1;
constexpr size_t OFF_KN = R1 + 32 * MiB;
constexpr size_t OFF_VBT = R1 + 64 * MiB;
constexpr size_t OFF_QPE = R1 + 96 * MiB;
constexpr size_t R2 = 143 * MiB;
constexpr size_t OFF_QA = R2;
constexpr size_t OFF_KA = R2 + 32 * MiB;
constexpr size_t OFF_VAT = R2 + 64 * MiB;
constexpr size_t OFF_CQ = R2 + 96 * MiB;
constexpr size_t OFF_CKV = R2 + 112 * MiB;
constexpr size_t OFF_KPE = R2 + 120 * MiB;
constexpr size_t OFF_GA = 265 * MiB;
constexpr size_t OFF_GB = 329 * MiB;
constexpr size_t OFF_YA = 393 * MiB;
constexpr size_t OFF_YB = 425 * MiB;
constexpr size_t OFF_MERGED = R2;
constexpr size_t OFF_X2 = OFF_GA;
constexpr size_t OFF_X2B = OFF_YA;
constexpr size_t OFF_QP = R1;
constexpr size_t OFF_PIDX = R1 + 128 * MiB;
constexpr size_t OFF_PG = R1 + 144 * MiB;
constexpr size_t OFF_PIDX16 = OFF_COSA;
constexpr size_t OFF_UB = R1 + 160 * MiB;
constexpr size_t OFF_VB = R1 + 192 * MiB;
constexpr size_t OFF_VB8 = R1 + 176 * MiB;
static_assert(OFF_VB + 32 * MiB <= OFF_GA, "overlay");

struct Params {
    const float* x; const int* pos; const float* mix_g; const float* w_in; const float* qn_g; const float* w_qup;
    const float* kvn_g; const float* w_kvup; const float* w_a; const float* w_b; const float* w_out; const float* ffn_g;
    const float* w_pq; const float* keys1; const float* keys2; const float* eu; const float* ev; const float* fin_g;
    float* out; char* ws;
};

typedef float f32x2 __attribute__((ext_vector_type(2)));
DI unsigned pk_bf16(float lo, float hi) { const f32x2 v = {lo, hi}; return __builtin_bit_cast(unsigned, __builtin_convertvector(v, bf16x2_t)); }
DI bf16_t f2bf(float x) { return (bf16_t)(pk_bf16(x, x) & 0xffffu); }
DI float bf_lo(unsigned w) { return __uint_as_float(w << 16); }
DI float bf_hi(unsigned w) { return __uint_as_float(w & 0xffff0000u); }
DI int tid_fresh() { int t = threadIdx.x; asm volatile("" : "+v"(t)); return t; }
DI float swap_add32(float a, float b) { const u32x2 r = __builtin_amdgcn_permlane32_swap(__float_as_uint(a), __float_as_uint(b), false, false); return __uint_as_float(r[0]) + __uint_as_float(r[1]); }
DI float swap_add16(float a, float b) { const u32x2 r = __builtin_amdgcn_permlane16_swap(__float_as_uint(a), __float_as_uint(b), false, false); return __uint_as_float(r[0]) + __uint_as_float(r[1]); }
template <int CTRL> DI float dpp_get(float v) { return __int_as_float(__builtin_amdgcn_update_dpp(0, __float_as_int(v), CTRL, 0xf, 0xf, false)); }
DI float wave_sum(float v) {
#pragma unroll
    for (int o = 32; o >= 1; o >>= 1) v += __shfl_xor(v, o);
    return v;
}
DI float fdot2(unsigned a, unsigned b, float c) { return __builtin_amdgcn_fdot2_f32_bf16(__builtin_bit_cast(bf16x2_t, a), __builtin_bit_cast(bf16x2_t, b), c, false); }
DI float dot8(const u32x4& a, const u32x4& b, float c) { c = fdot2(a.x, b.x, c); c = fdot2(a.y, b.y, c); c = fdot2(a.z, b.z, c); c = fdot2(a.w, b.w, c); return c; }
DI f32x2 fp8lo(unsigned w) { return __builtin_amdgcn_cvt_pk_f32_fp8((int)w, false); }
DI f32x2 fp8hi(unsigned w) { return __builtin_amdgcn_cvt_pk_f32_fp8((int)w, true); }
DI unsigned pack_fp8x4(float a, float b, float c, float d) { int r = 0; r = __builtin_amdgcn_cvt_pk_fp8_f32(a, b, r, false); r = __builtin_amdgcn_cvt_pk_fp8_f32(c, d, r, true); return (unsigned)r; }
constexpr float U8_SCALE = 64.0f, V8_SCALE = 16.0f;
#define MFMA16(a, b, c) __builtin_amdgcn_mfma_f32_16x16x32_bf16((a), (b), (c), 0, 0, 0)
#define MFMA32(a, b, c) __builtin_amdgcn_mfma_f32_32x32x16_bf16((a), (b), (c), 0, 0, 0)

template <class F>
DI void transpose_w(const float* __restrict__ W, int ldw, int K, int Nd, const float* __restrict__ g, bf16_t* __restrict__ Wt, F srccol, int gw, int nw, int lane) {
    const int nbn = Nd / 64, ntask = nbn * (K / 32);
    for (int task = gw; task < ntask; task += nw) {
        const int nb = task % nbn, kb = task / nbn;
        const int nd = nb * 64 + lane, sc = srccol(nd);
        unsigned w[16];
#pragma unroll
        for (int j = 0; j < 16; ++j) {
            const int k = kb * 32 + 2 * j;
            float a = 0.f, b = 0.f;
            if (sc >= 0) { a = W[(size_t)k * ldw + sc]; b = W[(size_t)(k + 1) * ldw + sc]; if (g) { a *= g[k]; b *= g[k + 1]; } }
            w[j] = pk_bf16(a, b);
        }
        u32x4* dst = (u32x4*)(Wt + (size_t)nd * K + kb * 32);
#pragma unroll
        for (int j = 0; j < 4; ++j) dst[j] = (u32x4){w[4 * j], w[4 * j + 1], w[4 * j + 2], w[4 * j + 3]};
    }
}

DI void phase_prep(const Params& P) {
    char* ws = P.ws;
    const int tid = tid_fresh(), lane = tid & 63;
    const int gw = blockIdx.x * NWV + (tid >> 6), nw = gridDim.x * NWV;
    const int gt = blockIdx.x * NTHR + tid, nt = gridDim.x * NTHR;
    {
        bf16_t* xb = (bf16_t*)(ws + OFF_XB); float* rinv1 = (float*)(ws + OFF_RINV1);
        for (int t = gw; t < T; t += nw) {
            const f32x4* src = (const f32x4*)(P.x + (size_t)t * DM);
            f32x4 v[4]; float ss = 0.f;
#pragma unroll
            for (int i = 0; i < 4; ++i) { v[i] = src[lane + 64 * i]; ss += v[i][0] * v[i][0] + v[i][1] * v[i][1] + v[i][2] * v[i][2] + v[i][3] * v[i][3]; }
            ss = wave_sum(ss);
            if (lane == 0) rinv1[t] = rsqrtf(ss * (1.0f / DM) + RMS_EPS);
            u32x2* dst = (u32x2*)(xb + (size_t)t * XB_LD);
#pragma unroll
            for (int i = 0; i < 4; ++i) dst[lane + 64 * i] = (u32x2){pk_bf16(v[i][0], v[i][1]), pk_bf16(v[i][2], v[i][3])};
        }
    }
    {
        float* cosA = (float*)(ws + OFF_COSA); float* sinA = (float*)(ws + OFF_SINA);
        float* cosB = (float*)(ws + OFF_COSB); float* sinB = (float*)(ws + OFF_SINB);
        const int i = gt & 31;
        const float fa = powf(10000.0f, -(float)(2 * i) / 64.0f);
        const float fb = powf(10000.0f, -(float)(2 * (i & 15)) / 32.0f);
        for (int idx = gt; idx < T * 32; idx += nt) {
            const int t = idx >> 5;
            const float pos = (float)P.pos[t];
            float sa, ca; sincosf(pos * fa, &sa, &ca);
            cosA[idx] = ca; sinA[idx] = sa;
            if (i < 16) {
                float sb, cb; sincosf(pos * fb, &sb, &cb);
                cosB[t * 16 + i] = cb; sinB[t * 16 + i] = sb;
            }
        }
    }
    transpose_w(P.w_in, 4000, 1024, 4096, P.mix_g, (bf16_t*)(ws + OFF_WTIN),
                [](int n) { return n < 1920 ? n : (n < 3968 ? n + 32 : (n < 4000 ? n - 3968 + 1920 : -1)); }, gw, nw, lane);
    transpose_w(P.w_qup, 768, 256, 768, P.qn_g, (bf16_t*)(ws + OFF_WTQUP),
                [](int n) { return n < 512 ? (n >> 6) * 96 + (n & 63) : ((n - 512) >> 5) * 96 + 64 + ((n - 512) & 31); }, gw, nw, lane);
    transpose_w(P.w_kvup, 1024, 128, 1024, P.kvn_g, (bf16_t*)(ws + OFF_WTKVUP),
                [](int n) { return n < 512 ? (n >> 6) * 128 + (n & 63) : ((n - 512) >> 6) * 128 + 64 + ((n - 512) & 63); }, gw, nw, lane);
    transpose_w(P.w_a, 1024, 512, 1024, nullptr, (bf16_t*)(ws + OFF_WTA), [](int n) { return n; }, gw, nw, lane);
    transpose_w(P.w_b, 1024, 512, 1024, nullptr, (bf16_t*)(ws + OFF_WTB), [](int n) { return n; }, gw, nw, lane);
    transpose_w(P.w_out, 1024, 1024, 1024, nullptr, (bf16_t*)(ws + OFF_WTOUT), [](int n) { return n; }, gw, nw, lane);
    transpose_w(P.w_pq, 2048, 1024, 2048, P.ffn_g, (bf16_t*)(ws + OFF_WTPQ), [](int n) { return n; }, gw, nw, lane);
    {
        bf16_t* kb = (bf16_t*)(ws + OFF_KEYS);
        for (int idx = gt; idx < 2 * 131072 / 4; idx += nt) {
            const int e = idx * 4; const float* src = e < 131072 ? P.keys1 + e : P.keys2 + (e - 131072);
            const f32x4 v = *(const f32x4*)src;
            *(u32x2*)(kb + e) = (u32x2){pk_bf16(v[0], v[1]), pk_bf16(v[2], v[3])};
        }
    }
}

constexpr int LSTR = 72;
constexpr int GEMM_LDS = 2 * 256 * LSTR * 2;
#define LDS_BARRIER() do { asm volatile("s_waitcnt lgkmcnt(0)" ::: "memory"); __builtin_amdgcn_s_barrier(); asm volatile("" ::: "memory"); } while (0)
#define LAS3 __attribute__((address_space(3)))
constexpr int GSTAGE = 65536;
template <bool ZERO>
DI void gemm_main(const bf16_t* __restrict__ A, int lda, const bf16_t* __restrict__ Bt, int ldb, int K, char* smem, f32x4 (&acc)[8][4]) {
    const int tid = tid_fresh(), lane = tid & 63, wid = __builtin_amdgcn_readfirstlane(tid >> 6), wr = wid >> 2, wc = wid & 3;
    const char* Ab = (const char*)A; const char* Bb = (const char*)Bt;
    unsigned aoff[4], boff[4];
#pragma unroll
    for (int i = 0; i < 4; ++i) {
        const int row = 8 * (wid + 8 * i) + (lane >> 3), c = (lane & 7) ^ ((row >> 1) & 7);
        aoff[i] = (unsigned)(row * lda + c * 8) * 2u; boff[i] = (unsigned)(row * ldb + c * 8) * 2u;
    }
#define GM_DMA(buf, kk) do { const char* a_ = Ab + (size_t)(kk) * 2; const char* b_ = Bb + (size_t)(kk) * 2; \
        _Pragma("unroll") for (int i = 0; i < 4; ++i) __builtin_amdgcn_global_load_lds((const unsigned*)(a_ + aoff[i]), (LAS3 unsigned*)(smem + (buf) * GSTAGE + (wid + 8 * i) * 1024), 16, 0, 0); \
        _Pragma("unroll") for (int i = 0; i < 4; ++i) __builtin_amdgcn_global_load_lds((const unsigned*)(b_ + boff[i]), (LAS3 unsigned*)(smem + (buf) * GSTAGE + 32768 + (wid + 8 * i) * 1024), 16, 0, 0); } while (0)
    if (ZERO) {
#pragma unroll
        for (int m = 0; m < 8; ++m)
#pragma unroll
            for (int n = 0; n < 4; ++n) acc[m][n] = (f32x4){0.f, 0.f, 0.f, 0.f};
    }
    const int sw = (lane & 15) >> 1, q4 = lane >> 4;
    const int abase = (128 * wr + (lane & 15)) * 128, bbase = 32768 + (64 * wc + (lane & 15)) * 128;
    const int sl0 = ((q4) ^ sw) * 16, sl1 = ((4 + q4) ^ sw) * 16;
    LDS_BARRIER();
    GM_DMA(0, 0);
    asm volatile("s_waitcnt vmcnt(0)" ::: "memory");
    LDS_BARRIER();
#pragma unroll 1
    for (int k0 = 0; k0 < K; k0 += 64) {
        const int cur = (k0 >> 6) & 1;
        if (k0 + 64 < K) GM_DMA(cur ^ 1, k0 + 64);
        const char* Sb = smem + cur * GSTAGE;
        bf16x8 bf0[4], bf1[4], afA[4], afB[4];
#define LD_B(dst, sl) do { _Pragma("unroll") for (int n = 0; n < 4; ++n) dst[n] = *(const bf16x8*)(Sb + bbase + n * 2048 + (sl)); } while (0)
#define LD_A(dst, mh, sl) do { _Pragma("unroll") for (int m = 0; m < 4; ++m) dst[m] = *(const bf16x8*)(Sb + abase + (4 * (mh) + m) * 2048 + (sl)); } while (0)
#define MM(mh, af, bf) do { _Pragma("unroll") for (int m = 0; m < 4; ++m) _Pragma("unroll") for (int n = 0; n < 4; ++n) acc[4 * (mh) + m][n] = MFMA16(bf[n], af[m], acc[4 * (mh) + m][n]); } while (0)
        LD_B(bf0, sl0); LD_A(afA, 0, sl0);
        __builtin_amdgcn_sched_barrier(0);
        LD_A(afB, 1, sl0);
        __builtin_amdgcn_sched_barrier(0);
        MM(0, afA, bf0);
        __builtin_amdgcn_sched_barrier(0);
        LD_B(bf1, sl1); LD_A(afA, 0, sl1);
        __builtin_amdgcn_sched_barrier(0);
        MM(1, afB, bf0);
        __builtin_amdgcn_sched_barrier(0);
        LD_A(afB, 1, sl1);
        __builtin_amdgcn_sched_barrier(0);
        MM(0, afA, bf1);
        __builtin_amdgcn_sched_barrier(0);
        MM(1, afB, bf1);
        __builtin_amdgcn_sched_barrier(0);
#undef LD_B
#undef LD_A
#undef MM
        asm volatile("s_waitcnt vmcnt(0)" ::: "memory");
        LDS_BARRIER();
    }
#undef GM_DMA
}

struct BlkMap { int xcd, rank, cnt, ok; };
DI unsigned xcc_id() { return (unsigned)__builtin_amdgcn_s_getreg((3 << 11) | 20) & 0xFu; }
DI int tile_count(const BlkMap& bm, int Mt, int Nt) { return bm.ok ? (Mt * Nt) >> 3 : Mt * Nt; }
DI int tile_first(const BlkMap& bm) { return bm.ok ? bm.rank : (int)blockIdx.x; }
DI int tile_step(const BlkMap& bm) { return bm.ok ? bm.cnt : (int)gridDim.x; }
DI void tile_map(const BlkMap& bm, int j, int Mt, int Nt, int& mt, int& nt) {
    if (bm.ok) {
        const int slot = j & 31, sid = (j >> 5) * 8 + bm.xcd, snn = Nt >> 2;
        const int sm = sid / snn, sn = sid % snn;
        mt = 8 * sm + (slot >> 2); nt = 4 * sn + (slot & 3);
    } else { mt = j / Nt; nt = j % Nt; }
}

constexpr int WST = 144;
constexpr int WST_BYTES = 128 * WST;
DI void stg_put(char* wl, int lrow, int lcol, const f32x4& v) { *(u32x2*)(wl + lrow * WST + lcol * 2) = (u32x2){pk_bf16(v[0], v[1]), pk_bf16(v[2], v[3])}; }
DI void stg_flush(char* wl, bf16_t* dst, size_t ld, int lane, int ncols = 64) {
    asm volatile("" : "+v"(lane) :: "memory");
    const int rr = lane >> 3, ch = lane & 7;
#pragma unroll 4
    for (int j = 0; j < 16; ++j) {
        const int row = 8 * j + rr;
        const u32x4 w = *(const u32x4*)(wl + row * WST + ch * 16);
        if (ch * 8 < ncols) *(u32x4*)(dst + (size_t)row * ld + ch * 8) = w;
    }
    asm volatile("" ::: "memory");
}
DI void st4(bf16_t* dst, const f32x4& v) { *(u32x2*)dst = (u32x2){pk_bf16(v[0], v[1]), pk_bf16(v[2], v[3])}; }

DI void phase_inproj(const Params& P, char* smem, const BlkMap& bm) {
    char* ws = P.ws;
    const bf16_t* xb = (const bf16_t*)(ws + OFF_XB); const bf16_t* wt = (const bf16_t*)(ws + OFF_WTIN);
    const float* rinv1 = (const float*)(ws + OFF_RINV1);
    const float* cosA = (const float*)(ws + OFF_COSA); const float* sinA = (const float*)(ws + OFF_SINA);
    const float* cosB = (const float*)(ws + OFF_COSB); const float* sinB = (const float*)(ws + OFF_SINB);
    bf16_t* qa = (bf16_t*)(ws + OFF_QA); bf16_t* ka = (bf16_t*)(ws + OFF_KA); bf16_t* vaT = (bf16_t*)(ws + OFF_VAT);
    bf16_t* cq = (bf16_t*)(ws + OFF_CQ); bf16_t* ckv = (bf16_t*)(ws + OFF_CKV); bf16_t* kpe = (bf16_t*)(ws + OFF_KPE);
    bf16_t* ga = (bf16_t*)(ws + OFF_GA); bf16_t* gb = (bf16_t*)(ws + OFF_GB);
    const int tid = tid_fresh(), lane = tid & 63, wid = __builtin_amdgcn_readfirstlane(tid >> 6), wr = wid >> 2, wc = wid & 3, q4 = lane >> 4;
    constexpr int Mt = T / 256, Nt = 16;
    for (int v = tile_first(bm); v < tile_count(bm, Mt, Nt); v += tile_step(bm)) {
        int mt, nt; tile_map(bm, v, Mt, Nt, mt, nt);
        const int row0 = mt * 256, col0 = nt * 256;
        f32x4 acc[8][4];
        gemm_main<true>(xb + (size_t)row0 * XB_LD, XB_LD, wt + (size_t)col0 * DM, DM, DM, smem, acc);
        const int cb = col0 + 64 * wc;
        char* wl = smem + wid * WST_BYTES;
        const size_t tw0 = (size_t)row0 + 128 * wr;
        const int lr0 = lane & 15;
        if (cb < 1024) {
            const bool isq = cb < 512;
#pragma unroll
            for (int m = 0; m < 8; ++m) {
                const size_t t = tw0 + 16 * m + lr0;
                const float sc = isq ? rinv1[t] * QS_A : rinv1[t];
#pragma unroll
                for (int n = 0; n < 2; ++n) {
                    const f32x4 c = *(const f32x4*)(cosA + t * 32 + 16 * n + 4 * q4), s = *(const f32x4*)(sinA + t * 32 + 16 * n + 4 * q4);
                    const f32x4 x1 = acc[m][n] * sc, x2 = acc[m][n + 2] * sc;
                    stg_put(wl, 16 * m + lr0, 16 * n + 4 * q4, x1 * c - x2 * s);
                    stg_put(wl, 16 * m + lr0, 32 + 16 * n + 4 * q4, x2 * c + x1 * s);
                }
                asm volatile("" ::: "memory");
            }
            stg_flush(wl, (isq ? qa : ka) + tw0 * 512 + (cb & 511), 512, lane);
        } else if (cb < 1536) {
            const int h = (cb - 1024) >> 6;
#pragma unroll
            for (int m = 0; m < 8; ++m) {
                const int t = (int)tw0 + 16 * m + lr0;
                const float r = rinv1[t];
                const int b = t >> 12, s = t & 4095;
                bf16_t* dst = vaT + ((size_t)(b * 8 + h) * 64 + 4 * q4) * SEQ + s;
#pragma unroll
                for (int n = 0; n < 4; ++n)
#pragma unroll
                    for (int i = 0; i < 4; ++i) dst[(size_t)(16 * n + i) * SEQ] = f2bf(acc[m][n][i] * r);
            }
        } else if (cb < 1920) {
#pragma unroll
            for (int m = 0; m < 8; ++m) {
                const float r = rinv1[tw0 + 16 * m + lr0];
#pragma unroll
                for (int n = 0; n < 4; ++n) stg_put(wl, 16 * m + lr0, 16 * n + 4 * q4, acc[m][n] * r);
                asm volatile("" ::: "memory");
            }
            if (cb < 1792) stg_flush(wl, cq + tw0 * 256 + (cb - 1536), 256, lane);
            else stg_flush(wl, ckv + tw0 * 128 + (cb - 1792), 128, lane);
        } else if (cb < 3968) {
#pragma unroll
            for (int m = 0; m < 8; ++m) {
                const float r = rinv1[tw0 + 16 * m + lr0];
#pragma unroll
                for (int n = 0; n < 4; ++n) {
                    f32x4 z = acc[m][n] * r, o;
#pragma unroll
                    for (int i = 0; i < 4; ++i) o[i] = __builtin_amdgcn_rcpf(1.0f + __expf(-z[i]));
                    stg_put(wl, 16 * m + lr0, 16 * n + 4 * q4, o);
                }
                asm volatile("" ::: "memory");
            }
            stg_flush(wl, (cb < 2944 ? ga + tw0 * 1024 + (cb - 1920) : gb + tw0 * 1024 + (cb - 2944)), 1024, lane);
        } else if (cb == 3968) {
#pragma unroll
            for (int m = 0; m < 8; ++m) {
                const size_t t = tw0 + 16 * m + lr0;
                const float r = rinv1[t];
                const f32x4 c = *(const f32x4*)(cosB + t * 16 + 4 * q4), s = *(const f32x4*)(sinB + t * 16 + 4 * q4);
                const f32x4 x1 = acc[m][0] * r, x2 = acc[m][1] * r;
                stg_put(wl, 16 * m + lr0, 4 * q4, x1 * c - x2 * s);
                stg_put(wl, 16 * m + lr0, 16 + 4 * q4, x2 * c + x1 * s);
                asm volatile("" ::: "memory");
            }
            stg_flush(wl, kpe + tw0 * 32, 32, lane, 32);
        }
    }
}

DI void row_rinv256(const bf16_t* __restrict__ A, int lda, int K, float* s_rinv) {
    const int tid = tid_fresh(), row = tid >> 1, hf = tid & 1;
    const u32x4* p = (const u32x4*)(A + (size_t)row * lda + hf * (K / 2));
    float ss = 0.f;
    for (int c = 0; c < K / 16; ++c) {
        const u32x4 w = p[c];
#pragma unroll
        for (int j = 0; j < 4; ++j) { const float a = bf_lo(w[j]), b = bf_hi(w[j]); ss += a * a + b * b; }
    }
    ss += __shfl_xor(ss, 1);
    if (!hf) s_rinv[row] = rsqrtf(ss / (float)K + RMS_EPS);
}

DI void phase_mla_up(const Params& P, char* smem) {
    char* ws = P.ws;
    const bf16_t* cq = (const bf16_t*)(ws + OFF_CQ); const bf16_t* ckv = (const bf16_t*)(ws + OFF_CKV);
    const bf16_t* wq = (const bf16_t*)(ws + OFF_WTQUP); const bf16_t* wkv = (const bf16_t*)(ws + OFF_WTKVUP);
    const float* cosB = (const float*)(ws + OFF_COSB); const float* sinB = (const float*)(ws + OFF_SINB);
    bf16_t* qn = (bf16_t*)(ws + OFF_QN); bf16_t* qpe = (bf16_t*)(ws + OFF_QPE); bf16_t* kn = (bf16_t*)(ws + OFF_KN); bf16_t* vbT = (bf16_t*)(ws + OFF_VBT);
    const bf16_t* ka = (const bf16_t*)(ws + OFF_KA); float* kmean = (float*)(ws + OFF_KMEAN);
    float* s_rinv = (float*)(smem + 2 * GEMM_LDS);
    char* wl = smem + (threadIdx.x >> 6) * WST_BYTES;
    const int tid = tid_fresh(), lane = tid & 63, wid = __builtin_amdgcn_readfirstlane(tid >> 6), wr = wid >> 2, wc = wid & 3, q4 = lane >> 4;
    constexpr int Mt = T / 256;
    constexpr int N_Q = Mt * 3, N_KV = Mt * 4, N_KM = 128;
    for (int v = blockIdx.x; v < N_Q; v += gridDim.x) {
        __syncthreads();
        {
            const int mt = v / 3, nt = v % 3, row0 = mt * 256, col0 = nt * 256;
            row_rinv256(cq + (size_t)row0 * 256, 256, 256, s_rinv);
            f32x4 acc[8][4];
            gemm_main<true>(cq + (size_t)row0 * 256, 256, wq + (size_t)col0 * 256, 256, 256, smem, acc);
            const int cb = col0 + 64 * wc;
#pragma unroll
            for (int m = 0; m < 8; ++m) {
                const int lr = 128 * wr + 16 * m + (lane & 15), t = row0 + lr;
                const float r = s_rinv[lr] * QS_B;
                if (cb < 512) {
#pragma unroll
                    for (int n = 0; n < 4; ++n) stg_put(wl, lr - 128 * wr, 16 * n + 4 * q4, acc[m][n] * r);
                } else {
                    const f32x4 c = *(const f32x4*)(cosB + (size_t)t * 16 + 4 * q4), s = *(const f32x4*)(sinB + (size_t)t * 16 + 4 * q4);
#pragma unroll
                    for (int pr = 0; pr < 2; ++pr) {
                        const f32x4 x1 = acc[m][2 * pr] * r, x2 = acc[m][2 * pr + 1] * r;
                        stg_put(wl, lr - 128 * wr, 32 * pr + 4 * q4, x1 * c - x2 * s);
                        stg_put(wl, lr - 128 * wr, 32 * pr + 16 + 4 * q4, x2 * c + x1 * s);
                    }
                }
            }
            if (cb < 512) stg_flush(wl, qn + ((size_t)row0 + 128 * wr) * 512 + cb, 512, lane);
            else stg_flush(wl, qpe + ((size_t)row0 + 128 * wr) * 256 + (cb - 512), 256, lane);
        }
    }
    for (int v = N_Q + blockIdx.x; v < N_Q + N_KV; v += gridDim.x) {
        __syncthreads();
        {
            const int u = v - N_Q, mt = u >> 2, nt = u & 3, row0 = mt * 256, col0 = nt * 256;
            row_rinv256(ckv + (size_t)row0 * 128, 128, 128, s_rinv);
            f32x4 acc[8][4];
            gemm_main<true>(ckv + (size_t)row0 * 128, 128, wkv + (size_t)col0 * 128, 128, 128, smem, acc);
            const int cb = col0 + 64 * wc;
#pragma unroll
            for (int m = 0; m < 8; ++m) {
                const int lr = 128 * wr + 16 * m + (lane & 15), t = row0 + lr;
                const float r = s_rinv[lr];
                if (cb < 512) {
#pragma unroll
                    for (int n = 0; n < 4; ++n) stg_put(wl, lr - 128 * wr, 16 * n + 4 * q4, acc[m][n] * r);
                } else {
                    const int h = (cb - 512) >> 6, b = t >> 12, s = t & 4095;
                    bf16_t* dst = vbT + ((size_t)(b * 8 + h) * 64 + 4 * q4) * SEQ + s;
#pragma unroll
                    for (int n = 0; n < 4; ++n)
#pragma unroll
                        for (int i = 0; i < 4; ++i) dst[(size_t)(16 * n + i) * SEQ] = f2bf(acc[m][n][i] * r);
                }
            }
            if (cb < 512) stg_flush(wl, kn + ((size_t)row0 + 128 * wr) * 512 + cb, 512, lane);
        }
    }
    for (int v = N_Q + N_KV + (int)((blockIdx.x + (gridDim.x >> 1)) % gridDim.x); v < N_Q + N_KV + N_KM; v += gridDim.x) {
        {
            const int u = v - N_Q - N_KV, b = u >> 4, blk = u & 15;
            if (tid < 256) {
                const unsigned* src = (const unsigned*)(ka + ((size_t)b * SEQ + blk * 256) * 512) + tid;
                float s0 = 0.f, s1 = 0.f;
                for (int rr = 0; rr < 256; ++rr) { const unsigned w = src[(size_t)rr * 256]; s0 += bf_lo(w); s1 += bf_hi(w); }
                const int c = 2 * tid, h = c >> 6, d = c & 63;
                float* dst = kmean + ((size_t)((b * 8 + h) * 16 + blk)) * 64 + d;
                dst[0] = s0 * (1.0f / 256.0f); dst[1] = s1 * (1.0f / 256.0f);
            }
        }
    }
}

constexpr int NSUB = 4, KVT = 32 * NSUB;
constexpr int VSTR = KVT + 4;
constexpr int ATT_V_OFF = 2 * KVT * 104 * 2;
constexpr int ATT_ITEM_OFF = ATT_V_OFF + 2 * 64 * VSTR * 2;
template <bool MOBA>
DI void attn_item(const Params& P, int bh, int qt, char* smem) {
    constexpr int DK = MOBA ? 64 : 96, KS = DK / 16, KSTR = DK + 8;
    char* ws = P.ws;
    bf16_t* Ks = (bf16_t*)smem; bf16_t* Vs = (bf16_t*)(smem + ATT_V_OFF);
    const int tid = tid_fresh(), lane = tid & 63, w = __builtin_amdgcn_readfirstlane(tid >> 6), ql = lane & 31, hh = lane >> 5;
    const int b = bh >> 3, h = bh & 7, s0 = qt * 256, sq = s0 + 32 * w + ql;
    const size_t tq = (size_t)b * SEQ + sq;
    const bf16_t* Kg = (const bf16_t*)(ws + (MOBA ? OFF_KA : OFF_KN));
    const bf16_t* kpe = (const bf16_t*)(ws + OFF_KPE);
    const bf16_t* vT = (const bf16_t*)(ws + (MOBA ? OFF_VAT : OFF_VBT)) + (size_t)bh * 64 * SEQ;
    bf16x8 qf[KS];
    if (MOBA) {
        const bf16_t* qa = (const bf16_t*)(ws + OFF_QA) + tq * 512 + h * 64 + 8 * hh;
#pragma unroll
        for (int ks = 0; ks < 4; ++ks) qf[ks] = *(const bf16x8*)(qa + 16 * ks);
    } else {
        const bf16_t* qn = (const bf16_t*)(ws + OFF_QN) + tq * 512 + h * 64 + 8 * hh;
        const bf16_t* qp = (const bf16_t*)(ws + OFF_QPE) + tq * 256 + h * 32 + 8 * hh;
#pragma unroll
        for (int ks = 0; ks < 4; ++ks) qf[ks] = *(const bf16x8*)(qn + 16 * ks);
#pragma unroll
        for (int ks = 4; ks < KS; ++ks) qf[ks] = *(const bf16x8*)(qp + 16 * (ks - 4));
    }
    unsigned selmask = 0xffffffffu;
    if (MOBA) {
        const int blk = qt;
        float qv[32];
#pragma unroll
        for (int ks = 0; ks < 4; ++ks) {
            const u32x4 wq = __builtin_bit_cast(u32x4, qf[ks]);
#pragma unroll
            for (int j = 0; j < 4; ++j) { qv[8 * ks + 2 * j] = bf_lo(wq[j]); qv[8 * ks + 2 * j + 1] = bf_hi(wq[j]); }
        }
        const float* km = (const float*)(ws + OFF_KMEAN) + (size_t)bh * 16 * 64 + 8 * hh;
        float g[16];
#pragma unroll
        for (int n = 0; n < 16; ++n) {
            float a = -INFINITY;
            if (n < blk) {
                a = 0.f;
#pragma unroll
                for (int ks = 0; ks < 4; ++ks) {
                    const f32x4 k0 = *(const f32x4*)(km + n * 64 + 16 * ks), k1 = *(const f32x4*)(km + n * 64 + 16 * ks + 4);
#pragma unroll
                    for (int j = 0; j < 4; ++j) { a += qv[8 * ks + j] * k0[j]; a += qv[8 * ks + 4 + j] * k1[j]; }
                }
                a += __shfl_xor(a, 32);
            }
            g[n] = a;
        }
        unsigned mask = 0u;
        if (blk <= 3) mask = (1u << blk) - 1u;
        else {
#pragma unroll
            for (int r = 0; r < 3; ++r) {
                float best = -INFINITY; int bi = 0;
#pragma unroll
                for (int n = 0; n < 16; ++n) if (g[n] > best) { best = g[n]; bi = n; }
                mask |= 1u << bi;
#pragma unroll
                for (int n = 0; n < 16; ++n) g[n] = (n == bi) ? -INFINITY : g[n];
            }
        }
        selmask = mask | (1u << blk);
    }
    const int krow = tid >> 3, kch = tid & 7;
    const int vd = tid >> 4, vch = tid & 15;
    const bf16_t* kp0 = Kg + ((size_t)b * SEQ + krow) * 512 + h * 64 + kch * 8;
    const bf16_t* kpp = kpe + ((size_t)b * SEQ + (tid >> 2)) * 32 + (tid & 3) * 8;
    const bf16_t* vp0 = vT + (size_t)vd * SEQ + vch * 8;
    u32x4 rk[3], rv[2];
    const int nkt = 2 * qt + 2;
#define ATT_GLOAD(kt) do { \
        rk[0] = *(const u32x4*)(kp0 + (size_t)(KVT * (kt)) * 512); rk[1] = *(const u32x4*)(kp0 + (size_t)(KVT * (kt) + 64) * 512); \
        if (!MOBA) rk[2] = *(const u32x4*)(kpp + (size_t)(KVT * (kt)) * 32); \
        rv[0] = *(const u32x4*)(vp0 + KVT * (kt)); rv[1] = *(const u32x4*)(vp0 + (size_t)32 * SEQ + KVT * (kt)); } while (0)
    ATT_GLOAD(0);
    f32x16 O[2];
#pragma unroll
    for (int i = 0; i < 16; ++i) { O[0][i] = 0.f; O[1][i] = 0.f; }
    float mrun = -INFINITY, lrun = 0.f;
    const int wq0 = s0 + 32 * w;
    for (int kt = 0; kt < nkt; ++kt) {
        bf16_t* Kb = Ks + (kt & 1) * KVT * KSTR; bf16_t* Vb = Vs + (kt & 1) * 64 * VSTR;
        *(u32x4*)(Kb + krow * KSTR + kch * 8) = rk[0];
        *(u32x4*)(Kb + (krow + 64) * KSTR + kch * 8) = rk[1];
        if (!MOBA) *(u32x4*)(Kb + (tid >> 2) * KSTR + 64 + (tid & 3) * 8) = rk[2];
        *(u32x2*)(Vb + vd * VSTR + vch * 8) = (u32x2){rv[0][0], rv[0][1]};
        *(u32x2*)(Vb + vd * VSTR + vch * 8 + 4) = (u32x2){rv[0][2], rv[0][3]};
        *(u32x2*)(Vb + (vd + 32) * VSTR + vch * 8) = (u32x2){rv[1][0], rv[1][1]};
        *(u32x2*)(Vb + (vd + 32) * VSTR + vch * 8 + 4) = (u32x2){rv[1][2], rv[1][3]};
        __syncthreads();
        if (kt + 1 < nkt) ATT_GLOAD(kt + 1);
        const int kbase = KVT * kt;
        if (kbase <= wq0 + 31) {
            f32x16 Sv[NSUB];
#pragma unroll
            for (int sub = 0; sub < NSUB; ++sub) {
#pragma unroll
                for (int i = 0; i < 16; ++i) Sv[sub][i] = 0.f;
#pragma unroll
                for (int ks = 0; ks < KS; ++ks) {
                    const bf16x8 kf = *(const bf16x8*)(Kb + (32 * sub + ql) * KSTR + 16 * ks + 8 * hh);
                    Sv[sub] = MFMA32(kf, qf[ks], Sv[sub]);
                }
            }
            if (kbase + KVT - 1 > wq0) {
#pragma unroll
                for (int sub = 0; sub < NSUB; ++sub) {
                    const int thr = sq - kbase - 32 * sub - 4 * hh;
#pragma unroll
                    for (int i = 0; i < 16; ++i) if (((i & 3) + 8 * (i >> 2)) > thr) Sv[sub][i] = -INFINITY;
                }
            }
            float mt = -INFINITY;
#pragma unroll
            for (int i = 0; i < 16; ++i) mt = fmaxf(fmaxf(mt, fmaxf(Sv[0][i], Sv[1][i])), fmaxf(Sv[2][i], Sv[3][i]));
            mt = fmaxf(mt, __shfl_xor(mt, 32));
            bool sel = true;
            if (MOBA) { sel = (selmask >> (kbase >> 8)) & 1u; if (!sel) mt = -INFINITY; }
            const bool need = mt > mrun + 8.0f;
            if (__builtin_amdgcn_ballot_w64(need) != 0ull) {
                const float mnew = fmaxf(mrun, mt);
                const float ms = (mnew == -INFINITY) ? 0.f : mnew;
                const float alpha = __builtin_amdgcn_exp2f(mrun - ms);
                lrun *= alpha; mrun = mnew;
#pragma unroll
                for (int i = 0; i < 16; ++i) { O[0][i] *= alpha; O[1][i] *= alpha; }
            }
            const float msafe = (mrun == -INFINITY) ? 0.f : mrun;
            const float msub = sel ? msafe : INFINITY;
            float psum = 0.f;
#pragma unroll
            for (int sub = 0; sub < NSUB; ++sub)
#pragma unroll
                for (int i = 0; i < 16; ++i) { const float pv = __builtin_amdgcn_exp2f(Sv[sub][i] - msub); Sv[sub][i] = pv; psum += pv; }
            lrun += psum;
#pragma unroll
            for (int sub = 0; sub < NSUB; ++sub)
#pragma unroll
                for (int s = 0; s < 2; ++s) {
                    u32x4 pw;
#pragma unroll
                    for (int j = 0; j < 4; ++j) pw[j] = pk_bf16(Sv[sub][8 * s + 2 * j], Sv[sub][8 * s + 2 * j + 1]);
                    const bf16x8 pf = __builtin_bit_cast(bf16x8, pw);
#pragma unroll
                    for (int dt = 0; dt < 2; ++dt) {
                        const bf16_t* vrow = Vb + (32 * dt + ql) * VSTR + 32 * sub + 16 * s + 4 * hh;
                        const u32x2 v0 = *(const u32x2*)vrow, v1 = *(const u32x2*)(vrow + 8);
                        const bf16x8 vf = __builtin_bit_cast(bf16x8, (u32x4){v0[0], v0[1], v1[0], v1[1]});
                        O[dt] = MFMA32(vf, pf, O[dt]);
                    }
                }
        }
    }
#undef ATT_GLOAD
    lrun += __shfl_xor(lrun, 32);
    const float inv = 1.0f / lrun;
    bf16_t* y = (bf16_t*)(ws + (MOBA ? OFF_YA : OFF_YB)) + tq * 512 + h * 64 + 4 * hh;
#pragma unroll
    for (int dt = 0; dt < 2; ++dt)
#pragma unroll
        for (int g = 0; g < 4; ++g)
            *(u32x2*)(y + 32 * dt + 8 * g) = (u32x2){pk_bf16(O[dt][4 * g] * inv, O[dt][4 * g + 1] * inv), pk_bf16(O[dt][4 * g + 2] * inv, O[dt][4 * g + 3] * inv)};
}

DI void phase_attn(const Params& P, char* smem, int ci = 0) {
    unsigned* ctr = (unsigned*)(P.ws + OFF_CTR) + ci;
    int* s_item = (int*)(smem + ATT_ITEM_OFF);
    for (;;) {
        __syncthreads();
        if (threadIdx.x == 0) *s_item = (int)atomicAdd(ctr, 1u);
        __syncthreads();
        const int item = *s_item;
        if (item >= 2048) break;
        const int qt = 15 - (item >> 7), rest = item & 127, bh = rest & 63;
        if (rest < 64) attn_item<false>(P, bh, qt, smem); else attn_item<true>(P, bh, qt, smem);
    }
}

DI void phase_merge(const Params& P, char* smem, const BlkMap& bm) {
    char* ws = P.ws;
    const bf16_t* ya = (const bf16_t*)(ws + OFF_YA); const bf16_t* yb = (const bf16_t*)(ws + OFF_YB);
    const bf16_t* wa = (const bf16_t*)(ws + OFF_WTA); const bf16_t* wb = (const bf16_t*)(ws + OFF_WTB);
    const bf16_t* ga = (const bf16_t*)(ws + OFF_GA); const bf16_t* gb = (const bf16_t*)(ws + OFF_GB);
    bf16_t* merged = (bf16_t*)(ws + OFF_MERGED);
    const int tid = tid_fresh(), lane = tid & 63, wid = __builtin_amdgcn_readfirstlane(tid >> 6), wr = wid >> 2, wc = wid & 3, q4 = lane >> 4;
    char* wl = smem + wid * WST_BYTES;
    constexpr int Mt = T / 256, Nt = 4;
    for (int v = tile_first(bm); v < tile_count(bm, Mt, Nt); v += tile_step(bm)) {
        int mt, nt; tile_map(bm, v, Mt, Nt, mt, nt);
        const int row0 = mt * 256, col0 = nt * 256;
        f32x4 acc[8][4];
        gemm_main<true>(ya + (size_t)row0 * 512, 512, wa + (size_t)col0 * 512, 512, 512, smem, acc);
#pragma unroll
        for (int m = 0; m < 8; ++m) {
            const size_t t = row0 + 128 * wr + 16 * m + (lane & 15);
#pragma unroll
            for (int n = 0; n < 4; ++n) {
                const int c = col0 + 64 * wc + 16 * n + 4 * q4;
                const u32x2 wa2 = *(const u32x2*)(ga + t * 1024 + c), wb2 = *(const u32x2*)(gb + t * 1024 + c);
                acc[m][n][0] *= bf_lo(wa2[0]) / fmaxf(bf_lo(wb2[0]), 1e-30f);
                acc[m][n][1] *= bf_hi(wa2[0]) / fmaxf(bf_hi(wb2[0]), 1e-30f);
                acc[m][n][2] *= bf_lo(wa2[1]) / fmaxf(bf_lo(wb2[1]), 1e-30f);
                acc[m][n][3] *= bf_hi(wa2[1]) / fmaxf(bf_hi(wb2[1]), 1e-30f);
            }
        }
        gemm_main<false>(yb + (size_t)row0 * 512, 512, wb + (size_t)col0 * 512, 512, 512, smem, acc);
#pragma unroll
        for (int m = 0; m < 8; ++m) {
            const size_t t = row0 + 128 * wr + 16 * m + (lane & 15);
#pragma unroll
            for (int n = 0; n < 4; ++n) {
                const int c = col0 + 64 * wc + 16 * n + 4 * q4;
                const u32x2 wb2 = *(const u32x2*)(gb + t * 1024 + c);
                f32x4 o;
                o[0] = fmaxf(bf_lo(wb2[0]), 1e-30f) * acc[m][n][0]; o[1] = fmaxf(bf_hi(wb2[0]), 1e-30f) * acc[m][n][1];
                o[2] = fmaxf(bf_lo(wb2[1]), 1e-30f) * acc[m][n][2]; o[3] = fmaxf(bf_hi(wb2[1]), 1e-30f) * acc[m][n][3];
                stg_put(wl, 16 * m + (lane & 15), 16 * n + 4 * q4, o);
            }
        }
        stg_flush(wl, merged + ((size_t)row0 + 128 * wr) * 1024 + col0 + 64 * wc, 1024, lane);
    }
}

DI void phase_outproj(const Params& P, char* smem, const BlkMap& bm) {
    char* ws = P.ws;
    const bf16_t* merged = (const bf16_t*)(ws + OFF_MERGED); const bf16_t* wo = (const bf16_t*)(ws + OFF_WTOUT);
    float* x2 = (float*)(ws + OFF_X2); bf16_t* x2b = (bf16_t*)(ws + OFF_X2B); float* ssq2 = (float*)(ws + OFF_SSQ2);
    const int tid = tid_fresh(), lane = tid & 63, wid = __builtin_amdgcn_readfirstlane(tid >> 6), wr = wid >> 2, wc = wid & 3, q4 = lane >> 4;
    char* wl = smem + wid * WST_BYTES;
    constexpr int Mt = T / 256, Nt = 4;
    for (int v = tile_first(bm); v < tile_count(bm, Mt, Nt); v += tile_step(bm)) {
        int mt, nt; tile_map(bm, v, Mt, Nt, mt, nt);
        const int row0 = mt * 256, col0 = nt * 256;
        f32x4 acc[8][4];
        gemm_main<true>(merged + (size_t)row0 * 1024, 1024, wo + (size_t)col0 * 1024, 1024, 1024, smem, acc);
#pragma unroll
        for (int m = 0; m < 8; ++m) {
            const size_t t = row0 + 128 * wr + 16 * m + (lane & 15);
            float ssp = 0.f;
#pragma unroll
            for (int n = 0; n < 4; ++n) {
                const int c = col0 + 64 * wc + 16 * n + 4 * q4;
                const f32x4 o = *(const f32x4*)(P.x + t * 1024 + c) + acc[m][n];
                *(f32x4*)(x2 + t * 1024 + c) = o;
                stg_put(wl, 16 * m + (lane & 15), 16 * n + 4 * q4, o);
                ssp += o[0] * o[0] + o[1] * o[1] + o[2] * o[2] + o[3] * o[3];
            }
            ssp += __shfl_xor(ssp, 16); ssp += __shfl_xor(ssp, 32);
            if (q4 == 0) atomicAdd(ssq2 + t, ssp);
        }
        stg_flush(wl, x2b + ((size_t)row0 + 128 * wr) * 1024 + col0 + 64 * wc, 1024, lane);
    }
}

DI int mono(int b) { return b ^ ((b >> 31) & 0x7fffffff); }
DI void ins16(int (&a)[16], int v) {
#pragma unroll
    for (int s = 0; s < 16; ++s) { const int t = max(a[s], v); v = min(a[s], v); a[s] = t; }
}
DI void cex(int& hi, int& lo) { const int a = max(hi, lo), b = min(hi, lo); hi = a; lo = b; }
DI void bitonic_merge16(int (&a)[16]) {
#pragma unroll
    for (int j = 8; j > 0; j >>= 1)
#pragma unroll
        for (int i = 0; i < 16; ++i) { const int l = i ^ j; if (l > i) cex(a[i], a[l]); }
}
DI void bitonic_sort16(int (&a)[16]) {
#pragma unroll
    for (int k = 2; k <= 16; k <<= 1)
#pragma unroll
        for (int j = k >> 1; j > 0; j >>= 1)
#pragma unroll
            for (int i = 0; i < 16; ++i) { const int l = i ^ j; if (l > i) { if ((i & k) == 0) cex(a[i], a[l]); else cex(a[l], a[i]); } }
}
DI void merge_top16(int (&x)[16], const int (&y)[16]) {
#pragma unroll
    for (int i = 0; i < 16; ++i) x[i] = max(x[i], y[15 - i]);
    bitonic_merge16(x);
}
DI float rinv2_of(const float* ssq2, size_t t) { return rsqrtf(ssq2[t] * (1.0f / DM) + RMS_EPS); }
DI void peer_topk_task(const Params& P, const bf16_t* qrow, size_t t, int h, unsigned* lw, int ql, int hh) {
    char* ws = P.ws;
    const bf16_t* keysb = (const bf16_t*)(ws + OFF_KEYS);
    int* pidx = (int*)(ws + OFF_PIDX); float* pg = (float*)(ws + OFF_PG);
    int a[2][16];
#pragma unroll
    for (int half = 0; half < 2; ++half) {
        bf16x8 qf[8];
#pragma unroll
        for (int ks = 0; ks < 8; ++ks) qf[ks] = *(const bf16x8*)(qrow + half * 128 + 16 * ks + 8 * hh);
        const bf16_t* kb = keysb + (size_t)((half * 8 + h) * 128) * 128 + 8 * hh;
#pragma unroll
        for (int nt = 0; nt < 4; ++nt) {
            f32x16 acc;
#pragma unroll
            for (int i = 0; i < 16; ++i) acc[i] = 0.f;
#pragma unroll
            for (int ks = 0; ks < 8; ++ks) {
                const bf16x8 kf = *(const bf16x8*)(kb + (size_t)(32 * nt + ql) * 128 + 16 * ks);
                acc = MFMA32(kf, qf[ks], acc);
            }
            int kk[16];
#pragma unroll
            for (int i = 0; i < 16; ++i) {
                const int n = 32 * nt + (i & 3) + 8 * (i >> 2) + 4 * hh;
                kk[i] = (mono(__float_as_int(acc[i])) & ~127) | (127 - n);
            }
            bitonic_sort16(kk);
            if (nt == 0) {
#pragma unroll
                for (int s = 0; s < 16; ++s) a[half][s] = kk[s];
            } else merge_top16(a[half], kk);
        }
        int pa[16];
#pragma unroll
        for (int s = 0; s < 16; ++s) pa[s] = __shfl_xor(a[half][s], 32);
        merge_top16(a[half], pa);
    }
    float f1[16], f2[16];
#pragma unroll
    for (int i = 0; i < 16; ++i) { f1[i] = __int_as_float(mono(a[0][i] & ~127)); f2[i] = __int_as_float(mono(a[1][i] & ~127)); }
#pragma unroll
    for (int k = 0; k < 4; ++k) {
        unsigned w1 = 0u, w2 = 0u;
#pragma unroll
        for (int j = 0; j < 4; ++j) { w1 |= (unsigned)(127 - (a[0][4 * k + j] & 127)) << (8 * j); w2 |= (unsigned)(127 - (a[1][4 * k + j] & 127)) << (8 * j); }
        lw[k] = w1; lw[4 + k] = w2;
    }
    int bb[16];
#pragma unroll
    for (int s = 0; s < 16; ++s) bb[s] = (int)0x80000000;
#pragma unroll
    for (int i = 0; i < 16; ++i)
#pragma unroll
        for (int j = 0; j < 16; ++j)
            if ((i + 1) * (j + 1) <= 16) {
                const float c = f1[i] + f2[j];
                const int key = (mono(__float_as_int(c)) & ~255) | (i << 4) | j;
                ins16(bb, key);
            }
    const float r2 = rinv2_of((const float*)(ws + OFF_SSQ2), t);
    float z[16], e[16], sum = 0.f;
#pragma unroll
    for (int r = 0; r < 16; ++r) z[r] = __int_as_float(mono(bb[r] & ~255)) * r2;
#pragma unroll
    for (int r = 0; r < 16; ++r) { e[r] = __expf(z[r] - z[0]); sum += e[r]; }
    const float inv = 1.0f / sum;
    if (hh == 0) {
        int id[16];
#pragma unroll
        for (int r = 0; r < 16; ++r) {
            const int cid = bb[r] & 255, i = cid >> 4, j = cid & 15;
            const unsigned w1 = lw[i >> 2], w2 = lw[4 + (j >> 2)];
            const int n1 = (w1 >> (8 * (i & 3))) & 255, n2 = (w2 >> (8 * (j & 3))) & 255;
            id[r] = n1 * 128 + n2;
        }
        int* di = pidx + t * 128 + h * 16; float* dg = pg + t * 128 + h * 16;
#pragma unroll
        for (int k = 0; k < 4; ++k) {
            *(u32x4*)(di + 4 * k) = (u32x4){(unsigned)id[4 * k], (unsigned)id[4 * k + 1], (unsigned)id[4 * k + 2], (unsigned)id[4 * k + 3]};
            *(f32x4*)(dg + 4 * k) = (f32x4){e[4 * k] * inv, e[4 * k + 1] * inv, e[4 * k + 2] * inv, e[4 * k + 3] * inv};
        }
        unsigned* d16 = (unsigned*)(ws + OFF_PIDX16) + t * 64 + h * 8;
#pragma unroll
        for (int k = 0; k < 2; ++k)
            *(u32x4*)(d16 + 4 * k) = (u32x4){(unsigned)id[8 * k] | ((unsigned)id[8 * k + 1] << 16), (unsigned)id[8 * k + 2] | ((unsigned)id[8 * k + 3] << 16),
                                              (unsigned)id[8 * k + 4] | ((unsigned)id[8 * k + 5] << 16), (unsigned)id[8 * k + 6] | ((unsigned)id[8 * k + 7] << 16)};
    }
}

DI void phase_peerq(const Params& P, char* smem, const BlkMap& bm) {
    char* ws = P.ws;
    const int tid = tid_fresh(), lane = tid & 63, wid = __builtin_amdgcn_readfirstlane(tid >> 6), wr = wid >> 2, wc = wid & 3, q4 = lane >> 4;
    const int gw = blockIdx.x * NWV + wid, nw = gridDim.x * NWV;
    const int gt = blockIdx.x * NTHR + tid, ntd = gridDim.x * NTHR;
    {
        unsigned* ub = (unsigned*)(ws + OFF_UB); unsigned* vb = (unsigned*)(ws + OFF_VB8);
        for (int idx = gt; idx < 16384 * 1024 / 16; idx += ntd) {
            const size_t e = (size_t)idx * 16; const int c = (int)(e & 1023);
            u32x4 uo, vo;
#pragma unroll
            for (int q = 0; q < 4; ++q) {
                const f32x4 g0 = *(const f32x4*)(P.ffn_g + c + 4 * q) * U8_SCALE;
                const f32x4 u0 = *(const f32x4*)(P.eu + e + 4 * q) * g0;
                const f32x4 v0 = *(const f32x4*)(P.ev + e + 4 * q) * V8_SCALE;
                uo[q] = pack_fp8x4(u0[0], u0[1], u0[2], u0[3]);
                vo[q] = pack_fp8x4(v0[0], v0[1], v0[2], v0[3]);
            }
            *(u32x4*)(ub + e / 4) = uo;
            *(u32x4*)(vb + e / 4) = vo;
        }
    }
    const bf16_t* x2b = (const bf16_t*)(ws + OFF_X2B); const bf16_t* wp = (const bf16_t*)(ws + OFF_WTPQ);
    constexpr int QIMG_STR = 528, QIMG_BYTES = 256 * QIMG_STR;
    constexpr int Mt = T / 256, Nt = 8;
    for (int v = tile_first(bm); v < tile_count(bm, Mt, Nt); v += tile_step(bm)) {
        int mt, nt; tile_map(bm, v, Mt, Nt, mt, nt);
        const int row0 = mt * 256, col0 = nt * 256;
        f32x4 acc[8][4];
        gemm_main<true>(x2b + (size_t)row0 * 1024, 1024, wp + (size_t)col0 * 1024, 1024, 1024, smem, acc);
        int lz = lane; asm volatile("" : "+v"(lz));
#pragma unroll
        for (int m = 0; m < 8; ++m) {
#pragma unroll
            for (int n = 0; n < 4; ++n) {
                const f32x4 v4 = acc[m][n];
                *(u32x2*)(smem + (128 * wr + 16 * m + (lz & 15)) * QIMG_STR + (64 * wc + 16 * n + 4 * (lz >> 4)) * 2) = (u32x2){pk_bf16(v4[0], v4[1]), pk_bf16(v4[2], v4[3])};
            }
        }
        __syncthreads();
        peer_topk_task(P, (const bf16_t*)(smem + (32 * wid + (lz & 31)) * QIMG_STR), (size_t)row0 + 32 * wid + (lz & 31), nt,
                       (unsigned*)(smem + QIMG_BYTES) + wid * 512 + lz * 8, lz & 31, lz >> 5);
    }
}

DI float reduce16(float (&p)[16], int lane) {
    const bool b5 = lane & 32, b4 = lane & 16, b3 = lane & 8, b2 = lane & 4;
    float r8[8], r4[4], r2[2];
#pragma unroll
    for (int i = 0; i < 8; ++i) { const float keep = b5 ? p[i + 8] : p[i], send = b5 ? p[i] : p[i + 8]; r8[i] = keep + __shfl_xor(send, 32); }
#pragma unroll
    for (int i = 0; i < 4; ++i) { const float keep = b4 ? r8[i + 4] : r8[i], send = b4 ? r8[i] : r8[i + 4]; r4[i] = keep + __shfl_xor(send, 16); }
#pragma unroll
    for (int i = 0; i < 2; ++i) { const float keep = b3 ? r4[i + 2] : r4[i], send = b3 ? r4[i] : r4[i + 2]; r2[i] = keep + __shfl_xor(send, 8); }
    const float keep = b2 ? r2[1] : r2[0], send = b2 ? r2[0] : r2[1];
    float r1 = keep + __shfl_xor(send, 4);
    r1 += __shfl_xor(r1, 2); r1 += __shfl_xor(r1, 1);
    return r1;
}
constexpr size_t OFF_PART = R1;
constexpr size_t OFF_SSQ = OFF_COSA;
DI bool slice_next(const BlkMap& bm, int it, int wid, int& t, int& x) {
    if (bm.ok) { t = bm.rank * NWV + wid + it * (32 * NWV); x = bm.xcd; return t < T; }
    const int p = (int)blockIdx.x * NWV + wid + it * (int)gridDim.x * NWV; t = p >> 3; x = p & 7; return p < T * 8;
}
DI void phase_exp_u(const Params& P, const BlkMap& bm) {
    char* ws = P.ws;
    const bf16_t* x2b = (const bf16_t*)(ws + OFF_X2B);
    const unsigned char* ub = (const unsigned char*)(ws + OFF_UB);
    const int* pidx = (const int*)(ws + OFF_PIDX);
    float* part = (float*)(ws + OFF_PART);
    const int tid = tid_fresh(), lane = tid & 63, wid = __builtin_amdgcn_readfirstlane(tid >> 6), g = lane >> 3, r = lane & 7;
    int t, x;
    for (int it = 0; slice_next(bm, it, wid, t, x); ++it) {
        f32x2 xv[8];
        {
            const bf16_t* xp = x2b + (size_t)t * 1024 + 128 * x + 16 * r;
            const u32x4 a = *(const u32x4*)xp, b = *(const u32x4*)(xp + 8);
#pragma unroll
            for (int j = 0; j < 4; ++j) { xv[j] = (f32x2){bf_lo(a[j]), bf_hi(a[j])}; xv[4 + j] = (f32x2){bf_lo(b[j]), bf_hi(b[j])}; }
        }
        int id[16];
#pragma unroll
        for (int q = 0; q < 2; ++q) {
            const u32x4 w = *(const u32x4*)((const unsigned*)(ws + OFF_PIDX16) + (size_t)t * 64 + g * 8 + 4 * q);
#pragma unroll
            for (int c = 0; c < 4; ++c) { id[8 * q + 2 * c] = (int)(w[c] & 0xffffu); id[8 * q + 2 * c + 1] = (int)(w[c] >> 16); }
        }
        u32x4 uu[16];
        const unsigned char* ubase = ub + 128 * x + 16 * r;
#pragma unroll
        for (int j = 0; j < 16; ++j) uu[j] = *(const u32x4*)(ubase + (size_t)id[j] * 1024);
        float p[16];
#pragma unroll
        for (int j = 0; j < 16; ++j) {
            f32x2 acc = {0.f, 0.f};
#pragma unroll
            for (int q = 0; q < 4; ++q) { acc = __builtin_elementwise_fma(fp8lo(uu[j][q]), xv[2 * q], acc); acc = __builtin_elementwise_fma(fp8hi(uu[j][q]), xv[2 * q + 1], acc); }
            p[j] = acc.x + acc.y;
        }
        const bool b4 = r & 4, b2 = r & 2, b1 = r & 1;
        float q8[8], q4v[4], q2[2];
#pragma unroll
        for (int i = 0; i < 8; ++i) { const float keep = b4 ? p[i + 8] : p[i], send = b4 ? p[i] : p[i + 8]; q8[i] = keep + __shfl_xor(send, 4); }
#pragma unroll
        for (int i = 0; i < 4; ++i) { const float keep = b2 ? q8[i + 4] : q8[i], send = b2 ? q8[i] : q8[i + 4]; q4v[i] = keep + dpp_get<0x4E>(send); }
#pragma unroll
        for (int i = 0; i < 2; ++i) { const float keep = b1 ? q4v[i + 2] : q4v[i], send = b1 ? q4v[i] : q4v[i + 2]; q2[i] = keep + dpp_get<0xB1>(send); }
        *(f32x2*)(part + ((size_t)x * T + t) * 128 + 2 * lane) = (f32x2){q2[0], q2[1]};
    }
}
DI void phase_exp_w(const Params& P) {
    char* ws = P.ws;
    const float* ssq2 = (const float*)(ws + OFF_SSQ2);
    float* pg = (float*)(ws + OFF_PG); const unsigned* pidx = (const unsigned*)(ws + OFF_PIDX);
    const float* part = (const float*)(ws + OFF_PART);
    const int tid = tid_fresh(), lane = tid & 63, wid = __builtin_amdgcn_readfirstlane(tid >> 6);
    const int gw = blockIdx.x * NWV + wid, nw = gridDim.x * NWV;
    for (int t = gw; t < T; t += nw) {
        f32x2 tot = {0.f, 0.f};
#pragma unroll
        for (int xx = 0; xx < 8; ++xx) tot += *(const f32x2*)(part + ((size_t)xx * T + t) * 128 + 2 * lane);
        const float r2 = rinv2_of(ssq2, t) * (1.0f / U8_SCALE);
        const f32x2 gg = *(const f32x2*)(pg + (size_t)t * 128 + 2 * lane);
        const float a0 = tot.x * r2, a1 = tot.y * r2;
        const float w0 = gg.x * 0.5f * a0 * (1.0f + erff(a0 * 0.70710678118654752f)) * (1.0f / V8_SCALE);
        const float w1 = gg.y * 0.5f * a1 * (1.0f + erff(a1 * 0.70710678118654752f)) * (1.0f / V8_SCALE);
        const u32x2 ids = *(const u32x2*)(pidx + (size_t)t * 128 + 2 * lane);
        *(u32x2*)(pg + (size_t)t * 128 + 2 * lane) = (u32x2){(ids[0] << 16) | (unsigned)f2bf(w0), (ids[1] << 16) | (unsigned)f2bf(w1)};
    }
}
DI void phase_exp_v(const Params& P, const BlkMap& bm, char* smem) {
    char* ws = P.ws;
    const float* x2 = (const float*)(ws + OFF_X2);
    const unsigned char* vb = (const unsigned char*)(ws + OFF_VB8);
    const float* rinv2 = (const float*)(ws + OFF_RINV2);
    const int* pidx = (const int*)(ws + OFF_PIDX); const float* pg = (const float*)(ws + OFF_PG);
    const float* part = (const float*)(ws + OFF_PART);
    float* ssq = (float*)(ws + OFF_SSQ);
    const int tid = tid_fresh(), lane = tid & 63, wid = __builtin_amdgcn_readfirstlane(tid >> 6), g = lane >> 3, r = lane & 7;
    int t, x;
    for (int it = 0; slice_next(bm, it, wid, t, x); ++it) {
        int id[16]; float wj[16];
#pragma unroll
        for (int q = 0; q < 4; ++q) {
            const u32x4 w = *(const u32x4*)((const unsigned*)pg + (size_t)t * 128 + g * 16 + 4 * q);
#pragma unroll
            for (int c = 0; c < 4; ++c) { id[4 * q + c] = (int)(w[c] >> 16); wj[4 * q + c] = __uint_as_float(w[c] << 16); }
        }
        u32x4 vv[16];
        const unsigned char* vbase = vb + 128 * x + 16 * r;
#pragma unroll
        for (int j = 0; j < 16; ++j) vv[j] = *(const u32x4*)(vbase + (size_t)id[j] * 1024);
        f32x2 out[8];
#pragma unroll
        for (int i = 0; i < 8; ++i) out[i] = (f32x2){0.f, 0.f};
#pragma unroll
        for (int j = 0; j < 16; ++j) {
            const f32x2 w2 = {wj[j], wj[j]};
#pragma unroll
            for (int q = 0; q < 4; ++q) { out[2 * q] = __builtin_elementwise_fma(fp8lo(vv[j][q]), w2, out[2 * q]); out[2 * q + 1] = __builtin_elementwise_fma(fp8hi(vv[j][q]), w2, out[2 * q + 1]); }
        }
        float o[16];
#pragma unroll
        for (int i = 0; i < 8; ++i) { o[2 * i] = out[i].x; o[2 * i + 1] = out[i].y; }
        const bool b5 = lane & 32, b4 = lane & 16, b3 = lane & 8;
        float q8[8], q4v[4], q2[2];
#pragma unroll
        for (int i = 0; i < 8; ++i) q8[i] = swap_add32(o[i], o[i + 8]);
#pragma unroll
        for (int i = 0; i < 4; ++i) q4v[i] = swap_add16(q8[i], q8[i + 4]);
#pragma unroll
        for (int i = 0; i < 2; ++i) { const float keep = b3 ? q4v[i + 2] : q4v[i], send = b3 ? q4v[i] : q4v[i + 2]; q2[i] = keep + dpp_get<0x128>(send); }
        const size_t col = (size_t)t * 1024 + 128 * x + 16 * r + 2 * g;
        const f32x2 xr = *(const f32x2*)(x2 + col);
        const float y0 = xr.x + q2[0], y1 = xr.y + q2[1];
        *(f32x2*)(P.out + col) = (f32x2){y0, y1};
    }
}
DI void phase_final_norm(const Params& P) {
    const int tid = tid_fresh(), lane = tid & 63, wid = __builtin_amdgcn_readfirstlane(tid >> 6);
    const int gw = blockIdx.x * NWV + wid, nw = gridDim.x * NWV;
    for (int t = gw; t < T; t += nw) {
        float* o = P.out + (size_t)t * 1024;
        f32x4 y[4]; float ss = 0.f;
#pragma unroll
        for (int i = 0; i < 4; ++i) { y[i] = *(const f32x4*)(o + 4 * (lane + 64 * i)); ss += y[i][0] * y[i][0] + y[i][1] * y[i][1] + y[i][2] * y[i][2] + y[i][3] * y[i][3]; }
        ss = wave_sum(ss);
        const float rinv = rsqrtf(ss * (1.0f / DM) + RMS_EPS);
#pragma unroll
        for (int i = 0; i < 4; ++i) { const int c = 4 * (lane + 64 * i); *(f32x4*)(o + c) = y[i] * rinv * *(const f32x4*)(P.fin_g + c); }
    }
}

#define XB_TMO      128
#define XB_XCNT(j)  (256  + 64 * (j))
#define XB_XSUB(j)  (1280 + 64 * (j))
#define XB_XGEN(j)  (2304 + 64 * (j))
#define XB_TOP      3328
#define XB_TOPGEN   3392
#define XCD_BAR_WORDS 3456
#define XB_SPIN_CAP (1u << 18)
#define LAS __attribute__((address_space(3)))
DI unsigned xb_ld(unsigned* p)              { return __hip_atomic_load(p, __ATOMIC_RELAXED, __HIP_MEMORY_SCOPE_AGENT); }
DI unsigned xb_add(unsigned* p, unsigned v) { return __hip_atomic_fetch_add(p, v, __ATOMIC_RELAXED, __HIP_MEMORY_SCOPE_AGENT); }
#define XB_SPIN(cond, bar) do { unsigned _sp = 0; while (cond) { __builtin_amdgcn_s_sleep(1); \
    if ((++_sp & 255u) == 0u) { if (xb_ld(&(bar)[XB_TMO])) break; if (_sp > XB_SPIN_CAP) { atomicAdd(&(bar)[XB_TMO], 1u); break; } } } } while (0)
struct XcdBarrier { unsigned* bar; unsigned x; volatile LAS unsigned* st; };
DI XcdBarrier xcd_barrier_post(unsigned* bar, volatile LAS unsigned* st) {
    XcdBarrier b; b.bar = bar; b.x = (unsigned)__builtin_amdgcn_s_getreg((3 << 11) | 20) & 0xFu; b.st = st;
    if (threadIdx.x == 0) (void)xb_add(&bar[XB_XCNT(b.x)], 1u);
    return b;
}
DI void xcd_barrier_complete(unsigned* bar, unsigned x, unsigned& nloc, unsigned& nx) {
    const unsigned G = gridDim.x * gridDim.y * gridDim.z;
    unsigned sum, cnt, mine, sp = 0u;
    for (;;) {
        sum = 0u; cnt = 0u; mine = 0u;
#pragma unroll
        for (unsigned j = 0; j < 16; ++j) { const unsigned c = xb_ld(&bar[XB_XCNT(j)]); sum += c; cnt += (c > 0u) ? 1u : 0u; mine = (j == x) ? c : mine; }
        if (sum == G) break;
        __builtin_amdgcn_s_sleep(1);
        if ((++sp & 255u) == 0u) { if (xb_ld(&bar[XB_TMO])) break; if (sp > XB_SPIN_CAP) { atomicAdd(&bar[XB_TMO], 1u); break; } }
    }
    nloc = mine > 0u ? mine : 1u; nx = cnt > 0u ? cnt : 1u;
}
DI void xcd_barrier(const XcdBarrier& b) {
    asm volatile("s_waitcnt vmcnt(0)" ::: "memory");
    __syncthreads();
    if (threadIdx.x == 0) {
        unsigned* bar = b.bar;
        __builtin_amdgcn_s_waitcnt(0);
        unsigned nloc = b.st[0], nx = b.st[1];
        if (nloc == 0u) { xcd_barrier_complete(bar, b.x, nloc, nx); b.st[0] = nloc; b.st[1] = nx; }
        const unsigned old = xb_add(&bar[XB_XSUB(b.x)], 1u);
        const unsigned gen = old / nloc;
        if (old + 1u == (gen + 1u) * nloc) {
            __builtin_amdgcn_fence(__ATOMIC_RELEASE, "agent");
            asm volatile("s_waitcnt vmcnt(0)" ::: "memory");
            const unsigned og = xb_add(&bar[XB_TOP], 1u);
            const unsigned tg = og / nx;
            if (og + 1u == (tg + 1u) * nx) xb_add(&bar[XB_TOPGEN], 1u);
            else XB_SPIN(xb_ld(&bar[XB_TOPGEN]) == tg, bar);
            __builtin_amdgcn_fence(__ATOMIC_ACQUIRE, "agent");
            xb_add(&bar[XB_XGEN(b.x)], 1u);
            asm volatile("s_waitcnt vmcnt(0)" ::: "memory");
        } else {
            XB_SPIN(xb_ld(&bar[XB_XGEN(b.x)]) == gen, bar);
            __builtin_amdgcn_fence(__ATOMIC_ACQUIRE, "agent");
            asm volatile("s_waitcnt vmcnt(0)" ::: "memory");
        }
    }
    __syncthreads();
}

constexpr int SMEM_BYTES = 152 * 1024;
constexpr int XB_ST_OFF = 150 * 1024;
template <bool COOP>
__global__ void __launch_bounds__(512) hybrid_fwd(Params P, int ph_lo, int ph_hi) {
    extern __shared__ __attribute__((aligned(16))) char smem[];
#ifndef PROBE_REP
#define PROBE_REP 0
#endif
    volatile LAS unsigned* xst = (volatile LAS unsigned*)(smem + XB_ST_OFF);
    if (threadIdx.x == 0) { xst[0] = 0u; xst[1] = 0u; xst[2] = 0u; xst[3] = 0u; }
    __syncthreads();
    XcdBarrier xb; xb.bar = (unsigned*)(P.ws + OFF_CTR) + 256; xb.x = 0u; xb.st = xst;
    if (COOP) xb = xcd_barrier_post((unsigned*)(P.ws + OFF_CTR) + 256, xst);
    BlkMap bm; bm.xcd = 0; bm.rank = 0; bm.cnt = 1; bm.ok = 0;
    unsigned* census = (unsigned*)(P.ws + OFF_CTR) + 16;
    if (COOP) {
        bm.xcd = (int)xcc_id() & 7;
        if (threadIdx.x == 0) *(int*)smem = (int)atomicAdd(census + bm.xcd, 1u);
        __syncthreads();
        bm.rank = __builtin_amdgcn_readfirstlane(*(int*)smem);
        __syncthreads();
    }
#define RUN_PHASE(k, call) do { if (COOP || (ph_lo <= (k) && (k) <= ph_hi)) { if (COOP && (k) == 1) cg::this_grid().sync(); else if (COOP && (k) > 1) xcd_barrier(xb); \
        if (COOP && (k) == 1) { int okk = 1; const int per = (int)gridDim.x >> 3; for (int x_ = 0; x_ < 8; ++x_) okk &= ((int)census[x_] == per); \
            bm.cnt = per; bm.ok = okk && ((gridDim.x & 7) == 0) && per == 32; } \
        call; \
        if (COOP && ((PROBE_REP >> (k)) & 1)) { cg::this_grid().sync(); if ((k) == 3) phase_attn(P, smem, 1); else { call; } } } } while (0)
    RUN_PHASE(0, phase_prep(P));
    RUN_PHASE(1, phase_inproj(P, smem, bm));
    RUN_PHASE(2, phase_mla_up(P, smem));
    RUN_PHASE(3, phase_attn(P, smem));
    RUN_PHASE(4, phase_merge(P, smem, bm));
    RUN_PHASE(5, phase_outproj(P, smem, bm));
    RUN_PHASE(6, phase_peerq(P, smem, bm));
    RUN_PHASE(8, phase_exp_u(P, bm));
    RUN_PHASE(9, phase_exp_w(P));
    RUN_PHASE(10, phase_exp_v(P, bm, smem));
    RUN_PHASE(11, phase_final_norm(P));
#undef RUN_PHASE
}

extern "C" void kernel_launch(void* const* d_in, const int* in_sizes, int n_in, void* d_out, int out_size, void* d_ws, size_t ws_size, hipStream_t stream) {
    Params p{};
    p.x = (const float*)d_in[0]; p.pos = (const int*)d_in[1]; p.mix_g = (const float*)d_in[2]; p.w_in = (const float*)d_in[3];
    p.qn_g = (const float*)d_in[4]; p.w_qup = (const float*)d_in[5]; p.kvn_g = (const float*)d_in[6]; p.w_kvup = (const float*)d_in[7];
    p.w_a = (const float*)d_in[8]; p.w_b = (const float*)d_in[9]; p.w_out = (const float*)d_in[10]; p.ffn_g = (const float*)d_in[11];
    p.w_pq = (const float*)d_in[12]; p.keys1 = (const float*)d_in[13]; p.keys2 = (const float*)d_in[14]; p.eu = (const float*)d_in[15];
    p.ev = (const float*)d_in[16]; p.fin_g = (const float*)d_in[17];
    p.out = (float*)d_out; p.ws = (char*)d_ws;
    static int grid_blocks = 0;
    if (!grid_blocks) {
        int dev = 0, cus = 0, per_cu = 0;
        hipGetDevice(&dev);
        hipDeviceGetAttribute(&cus, hipDeviceAttributeMultiprocessorCount, dev);
#if MK_COOP
        hipFuncSetAttribute((const void*)hybrid_fwd<true>, hipFuncAttributeMaxDynamicSharedMemorySize, SMEM_BYTES);
        hipOccupancyMaxActiveBlocksPerMultiprocessor(&per_cu, hybrid_fwd<true>, NTHR, SMEM_BYTES);
#else
        hipFuncSetAttribute((const void*)hybrid_fwd<false>, hipFuncAttributeMaxDynamicSharedMemorySize, SMEM_BYTES);
        hipOccupancyMaxActiveBlocksPerMultiprocessor(&per_cu, hybrid_fwd<false>, NTHR, SMEM_BYTES);
#endif
        if (per_cu < 1) per_cu = 1;
        grid_blocks = cus * per_cu;
    }
#if MK_COOP
    hipMemsetAsync((char*)d_ws + OFF_CTR, 0, CTR_MEMSET_BYTES, stream);
    int lo = 0, hi = 11;
    void* args[] = {&p, &lo, &hi};
    hipError_t e = hipLaunchCooperativeKernel((void*)hybrid_fwd<true>, dim3(grid_blocks), dim3(NTHR), args, SMEM_BYTES, stream);
    if (e != hipSuccess) fprintf(stderr, "cooperative launch failed: %s (grid %d)\n", hipGetErrorString(e), grid_blocks);
#else
    hipMemsetAsync((char*)d_ws + OFF_CTR, 0, CTR_MEMSET_BYTES, stream);
    for (int ph = 0; ph <= 11; ++ph) hipLaunchKernelGGL(hybrid_fwd<false>, dim3(grid_blocks), dim3(NTHR), SMEM_BYTES, stream, p, ph, ph);
#endif
}
```

```cpp
#include <hip/hip_runtime.h>
#include <hip/hip_cooperative_groups.h>
#include <cstdio>
#include <cstdint>
namespace cg = cooperative_groups;

#ifndef MK_COOP
#define MK_COOP 1
#endif

typedef unsigned short bf16_t;
typedef short bf16x8 __attribute__((ext_vector_type(8)));
typedef float f32x4 __attribute__((ext_vector_type(4)));
typedef float f32x16 __attribute__((ext_vector_type(16)));
typedef unsigned u32x4 __attribute__((ext_vector_type(4)));
typedef unsigned u32x2 __attribute__((ext_vector_type(2)));
typedef __bf16 bf16x2_t __attribute__((ext_vector_type(2)));

#define DI __device__ __forceinline__

constexpr int T = 32768, SEQ = 4096, DM = 1024;
constexpr int NTHR = 512, NWV = 8;
constexpr int XB_LD = 1088;
constexpr float RMS_EPS = 1e-6f;
constexpr float LOG2E = 1.4426950408889634f;
constexpr float QS_A = 0.125f * LOG2E;
constexpr float QS_B = 0.10206207261596577f * LOG2E;

constexpr size_t MiB = 1ull << 20;
constexpr size_t OFF_WTIN = 0;
constexpr size_t OFF_WTQUP = 8 * MiB;
constexpr size_t OFF_WTKVUP = 8 * MiB + 512 * 1024;
constexpr size_t OFF_WTA = 9 * MiB;
constexpr size_t OFF_WTB = 10 * MiB;
constexpr size_t OFF_WTOUT = 11 * MiB;
constexpr size_t OFF_WTPQ = 13 * MiB;
constexpr size_t OFF_KEYS = 17 * MiB;
constexpr size_t OFF_COSA = 18 * MiB;
constexpr size_t OFF_SINA = 22 * MiB;
constexpr size_t OFF_COSB = 26 * MiB;
constexpr size_t OFF_SINB = 28 * MiB;
constexpr size_t OFF_RINV1 = 30 * MiB;
constexpr size_t OFF_RINV2 = 30 * MiB + 128 * 1024;
constexpr size_t OFF_KMEAN = 30 * MiB + 256 * 1024;
constexpr size_t OFF_CTR = 30 * MiB + 512 * 1024;
constexpr size_t OFF_SSQ2 = OFF_CTR + 32 * 1024;
constexpr size_t CTR_MEMSET_BYTES = 160 * 1024;
constexpr size_t R1 = 31 * MiB;
constexpr size_t OFF_XB = R1;
constexpr size_t OFF_QN = R1;
constexpr size_t OFF_KN = R1 + 32 * MiB;
constexpr size_t OFF_VBT = R1 + 64 * MiB;
constexpr size_t OFF_QPE = R1 + 96 * MiB;
constexpr size_t R2 = 143 * MiB;
constexpr size_t OFF_QA = R2;
constexpr size_t OFF_KA = R2 + 32 * MiB;
constexpr size_t OFF_VAT = R2 + 64 * MiB;
constexpr size_t OFF_CQ = R2 + 96 * MiB;
constexpr size_t OFF_CKV = R2 + 112 * MiB;
constexpr size_t OFF_KPE = R2 + 120 * MiB;
constexpr size_t OFF_GA = 265 * MiB;
constexpr size_t OFF_GB = 329 * MiB;
constexpr size_t OFF_YA = 393 * MiB;
constexpr size_t OFF_YB = 425 * MiB;
constexpr size_t OFF_MERGED = R2;
constexpr size_t OFF_X2 = OFF_GA;
constexpr size_t OFF_X2B = OFF_YA;
constexpr size_t OFF_QP = R1;
constexpr size_t OFF_PIDX = R1 + 128 * MiB;
constexpr size_t OFF_PG = R1 + 144 * MiB;
constexpr size_t OFF_PIDX16 = OFF_COSA;
constexpr size_t OFF_UB = R1 + 160 * MiB;
constexpr size_t OFF_VB = R1 + 192 * MiB;
constexpr size_t OFF_VB8 = R1 + 176 * MiB;
static_assert(OFF_VB + 32 * MiB <= OFF_GA, "overlay");

struct Params {
    const float* x; const int* pos; const float* mix_g; const float* w_in; const float* qn_g; const float* w_qup;
    const float* kvn_g; const float* w_kvup; const float* w_a; const float* w_b; const float* w_out; const float* ffn_g;
    const float* w_pq; const float* keys1; const float* keys2; const float* eu; const float* ev; const float* fin_g;
    float* out; char* ws;
};

typedef float f32x2 __attribute__((ext_vector_type(2)));
DI unsigned pk_bf16(float lo, float hi) { const f32x2 v = {lo, hi}; return __builtin_bit_cast(unsigned, __builtin_convertvector(v, bf16x2_t)); }
DI bf16_t f2bf(float x) { return (bf16_t)(pk_bf16(x, x) & 0xffffu); }
DI float bf_lo(unsigned w) { return __uint_as_float(w << 16); }
DI float bf_hi(unsigned w) { return __uint_as_float(w & 0xffff0000u); }
DI int tid_fresh() { int t = threadIdx.x; asm volatile("" : "+v"(t)); return t; }
DI float swap_add32(float a, float b) { const u32x2 r = __builtin_amdgcn_permlane32_swap(__float_as_uint(a), __float_as_uint(b), false, false); return __uint_as_float(r[0]) + __uint_as_float(r[1]); }
DI float swap_add16(float a, float b) { const u32x2 r = __builtin_amdgcn_permlane16_swap(__float_as_uint(a), __float_as_uint(b), false, false); return __uint_as_float(r[0]) + __uint_as_float(r[1]); }
template <int CTRL> DI float dpp_get(float v) { return __int_as_float(__builtin_amdgcn_update_dpp(0, __float_as_int(v), CTRL, 0xf, 0xf, false)); }
DI float wave_sum(float v) {
#pragma unroll
    for (int o = 32; o >= 1; o >>= 1) v += __shfl_xor(v, o);
    return v;
}
DI float fdot2(unsigned a, unsigned b, float c) { return __builtin_amdgcn_fdot2_f32_bf16(__builtin_bit_cast(bf16x2_t, a), __builtin_bit_cast(bf16x2_t, b), c, false); }
DI float dot8(const u32x4& a, const u32x4& b, float c) { c = fdot2(a.x, b.x, c); c = fdot2(a.y, b.y, c); c = fdot2(a.z, b.z, c); c = fdot2(a.w, b.w, c); return c; }
DI f32x2 fp8lo(unsigned w) { return __builtin_amdgcn_cvt_pk_f32_fp8((int)w, false); }
DI f32x2 fp8hi(unsigned w) { return __builtin_amdgcn_cvt_pk_f32_fp8((int)w, true); }
DI unsigned pack_fp8x4(float a, float b, float c, float d) { int r = 0; r = __builtin_amdgcn_cvt_pk_fp8_f32(a, b, r, false); r = __builtin_amdgcn_cvt_pk_fp8_f32(c, d, r, true); return (unsigned)r; }
constexpr float U8_SCALE = 64.0f, V8_SCALE = 16.0f;
#define MFMA16(a, b, c) __builtin_amdgcn_mfma_f32_16x16x32_bf16((a), (b), (c), 0, 0, 0)
#define MFMA32(a, b, c) __builtin_amdgcn_mfma_f32_32x32x16_bf16((a), (b), (c), 0, 0, 0)

template <class F>
DI void transpose_w(const float* __restrict__ W, int ldw, int K, int Nd, const float* __restrict__ g, bf16_t* __restrict__ Wt, F srccol, int gw, int nw, int lane) {
    const int nbn = Nd / 64, ntask = nbn * (K / 32);
    for (int task = gw; task < ntask; task += nw) {
        const int nb = task % nbn, kb = task / nbn;
        const int nd = nb * 64 + lane, sc = srccol(nd);
        unsigned w[16];
#pragma unroll
        for (int j = 0; j < 16; ++j) {
            const int k = kb * 32 + 2 * j;
            float a = 0.f, b = 0.f;
            if (sc >= 0) { a = W[(size_t)k * ldw + sc]; b = W[(size_t)(k + 1) * ldw + sc]; if (g) { a *= g[k]; b *= g[k + 1]; } }
            w[j] = pk_bf16(a, b);
        }
        u32x4* dst = (u32x4*)(Wt + (size_t)nd * K + kb * 32);
#pragma unroll
        for (int j = 0; j < 4; ++j) dst[j] = (u32x4){w[4 * j], w[4 * j + 1], w[4 * j + 2], w[4 * j + 3]};
    }
}

DI void phase_prep(const Params& P) {
    char* ws = P.ws;
    const int tid = tid_fresh(), lane = tid & 63;
    const int gw = blockIdx.x * NWV + (tid >> 6), nw = gridDim.x * NWV;
    const int gt = blockIdx.x * NTHR + tid, nt = gridDim.x * NTHR;
    {
        bf16_t* xb = (bf16_t*)(ws + OFF_XB); float* rinv1 = (float*)(ws + OFF_RINV1);
        for (int t = gw; t < T; t += nw) {
            const f32x4* src = (const f32x4*)(P.x + (size_t)t * DM);
            f32x4 v[4]; float ss = 0.f;
#pragma unroll
            for (int i = 0; i < 4; ++i) { v[i] = src[lane + 64 * i]; ss += v[i][0] * v[i][0] + v[i][1] * v[i][1] + v[i][2] * v[i][2] + v[i][3] * v[i][3]; }
            ss = wave_sum(ss);
            if (lane == 0) rinv1[t] = rsqrtf(ss * (1.0f / DM) + RMS_EPS);
            u32x2* dst = (u32x2*)(xb + (size_t)t * XB_LD);
#pragma unroll
            for (int i = 0; i < 4; ++i) dst[lane + 64 * i] = (u32x2){pk_bf16(v[i][0], v[i][1]), pk_bf16(v[i][2], v[i][3])};
        }
    }
    {
        float* cosA = (float*)(ws + OFF_COSA); float* sinA = (float*)(ws + OFF_SINA);
        float* cosB = (float*)(ws + OFF_COSB); float* sinB = (float*)(ws + OFF_SINB);
        const int i = gt & 31;
        const float fa = powf(10000.0f, -(float)(2 * i) / 64.0f);
        const float fb = powf(10000.0f, -(float)(2 * (i & 15)) / 32.0f);
        for (int idx = gt; idx < T * 32; idx += nt) {
            const int t = idx >> 5;
            const float pos = (float)P.pos[t];
            float sa, ca; sincosf(pos * fa, &sa, &ca);
            cosA[idx] = ca; sinA[idx] = sa;
            if (i < 16) {
                float sb, cb; sincosf(pos * fb, &sb, &cb);
                cosB[t * 16 + i] = cb; sinB[t * 16 + i] = sb;
            }
        }
    }
    transpose_w(P.w_in, 4000, 1024, 4096, P.mix_g, (bf16_t*)(ws + OFF_WTIN),
                [](int n) { return n < 1920 ? n : (n < 3968 ? n + 32 : (n < 4000 ? n - 3968 + 1920 : -1)); }, gw, nw, lane);
    transpose_w(P.w_qup, 768, 256, 768, P.qn_g, (bf16_t*)(ws + OFF_WTQUP),
                [](int n) { return n < 512 ? (n >> 6) * 96 + (n & 63) : ((n - 512) >> 5) * 96 + 64 + ((n - 512) & 31); }, gw, nw, lane);
    transpose_w(P.w_kvup, 1024, 128, 1024, P.kvn_g, (bf16_t*)(ws + OFF_WTKVUP),
                [](int n) { return n < 512 ? (n >> 6) * 128 + (n & 63) : ((n - 512) >> 6) * 128 + 64 + ((n - 512) & 63); }, gw, nw, lane);
    transpose_w(P.w_a, 1024, 512, 1024, nullptr, (bf16_t*)(ws + OFF_WTA), [](int n) { return n; }, gw, nw, lane);
    transpose_w(P.w_b, 1024, 512, 1024, nullptr, (bf16_t*)(ws + OFF_WTB), [](int n) { return n; }, gw, nw, lane);
    transpose_w(P.w_out, 1024, 1024, 1024, nullptr, (bf16_t*)(ws + OFF_WTOUT), [](int n) { return n; }, gw, nw, lane);
    transpose_w(P.w_pq, 2048, 1024, 2048, P.ffn_g, (bf16_t*)(ws + OFF_WTPQ), [](int n) { return n; }, gw, nw, lane);
    {
        bf16_t* kb = (bf16_t*)(ws + OFF_KEYS);
        for (int idx = gt; idx < 2 * 131072 / 4; idx += nt) {
            const int e = idx * 4; const float* src = e < 131072 ? P.keys1 + e : P.keys2 + (e - 131072);
            const f32x4 v = *(const f32x4*)src;
            *(u32x2*)(kb + e) = (u32x2){pk_bf16(v[0], v[1]), pk_bf16(v[2], v[3])};
        }
    }
}

constexpr int LSTR = 72;
constexpr int GEMM_LDS = 2 * 256 * LSTR * 2;
#define LDS_BARRIER() do { asm volatile("s_waitcnt lgkmcnt(0)" ::: "memory"); __builtin_amdgcn_s_barrier(); asm volatile("" ::: "memory"); } while (0)
#define LAS3 __attribute__((address_space(3)))
constexpr int GSTAGE = 65536;
template <bool ZERO>
DI void gemm_main(const bf16_t* __restrict__ A, int lda, const bf16_t* __restrict__ Bt, int ldb, int K, char* smem, f32x4 (&acc)[8][4]) {
    const int tid = tid_fresh(), lane = tid & 63, wid = __builtin_amdgcn_readfirstlane(tid >> 6), wr = wid >> 2, wc = wid & 3;
    const char* Ab = (const char*)A; const char* Bb = (const char*)Bt;
    unsigned aoff[4], boff[4];
#pragma unroll
    for (int i = 0; i < 4; ++i) {
        const int row = 8 * (wid + 8 * i) + (lane >> 3), c = (lane & 7) ^ ((row >> 1) & 7);
        aoff[i] = (unsigned)(row * lda + c * 8) * 2u; boff[i] = (unsigned)(row * ldb + c * 8) * 2u;
    }
#define GM_DMA(buf, kk) do { const char* a_ = Ab + (size_t)(kk) * 2; const char* b_ = Bb + (size_t)(kk) * 2; \
        _Pragma("unroll") for (int i = 0; i < 4; ++i) __builtin_amdgcn_global_load_lds((const unsigned*)(a_ + aoff[i]), (LAS3 unsigned*)(smem + (buf) * GSTAGE + (wid + 8 * i) * 1024), 16, 0, 0); \
        _Pragma("unroll") for (int i = 0; i < 4; ++i) __builtin_amdgcn_global_load_lds((const unsigned*)(b_ + boff[i]), (LAS3 unsigned*)(smem + (buf) * GSTAGE + 32768 + (wid + 8 * i) * 1024), 16, 0, 0); } while (0)
    if (ZERO) {
#pragma unroll
        for (int m = 0; m < 8; ++m)
#pragma unroll
            for (int n = 0; n < 4; ++n) acc[m][n] = (f32x4){0.f, 0.f, 0.f, 0.f};
    }
    const int sw = (lane & 15) >> 1, q4 = lane >> 4;
    const int abase = (128 * wr + (lane & 15)) * 128, bbase = 32768 + (64 * wc + (lane & 15)) * 128;
    const int sl0 = ((q4) ^ sw) * 16, sl1 = ((4 + q4) ^ sw) * 16;
    LDS_BARRIER();
    GM_DMA(0, 0);
    asm volatile("s_waitcnt vmcnt(0)" ::: "memory");
    LDS_BARRIER();
#pragma unroll 1
    for (int k0 = 0; k0 < K; k0 += 64) {
        const int cur = (k0 >> 6) & 1;
        if (k0 + 64 < K) GM_DMA(cur ^ 1, k0 + 64);
        const char* Sb = smem + cur * GSTAGE;
        bf16x8 bf0[4], bf1[4], afA[4], afB[4];
#define LD_B(dst, sl) do { _Pragma("unroll") for (int n = 0; n < 4; ++n) dst[n] = *(const bf16x8*)(Sb + bbase + n * 2048 + (sl)); } while (0)
#define LD_A(dst, mh, sl) do { _Pragma("unroll") for (int m = 0; m < 4; ++m) dst[m] = *(const bf16x8*)(Sb + abase + (4 * (mh) + m) * 2048 + (sl)); } while (0)
#define MM(mh, af, bf) do { _Pragma("unroll") for (int m = 0; m < 4; ++m) _Pragma("unroll") for (int n = 0; n < 4; ++n) acc[4 * (mh) + m][n] = MFMA16(bf[n], af[m], acc[4 * (mh) + m][n]); } while (0)
        LD_B(bf0, sl0); LD_A(afA, 0, sl0);
        __builtin_amdgcn_sched_barrier(0);
        LD_A(afB, 1, sl0);
        __builtin_amdgcn_sched_barrier(0);
        MM(0, afA, bf0);
        __builtin_amdgcn_sched_barrier(0);
        LD_B(bf1, sl1); LD_A(afA, 0, sl1);
        __builtin_amdgcn_sched_barrier(0);
        MM(1, afB, bf0);
        __builtin_amdgcn_sched_barrier(0);
        LD_A(afB, 1, sl1);
        __builtin_amdgcn_sched_barrier(0);
        MM(0, afA, bf1);
        __builtin_amdgcn_sched_barrier(0);
        MM(1, afB, bf1);
        __builtin_amdgcn_sched_barrier(0);
#undef LD_B
#undef LD_A
#undef MM
        asm volatile("s_waitcnt vmcnt(0)" ::: "memory");
        LDS_BARRIER();
    }
#undef GM_DMA
}

struct BlkMap { int xcd, rank, cnt, ok; };
DI unsigned xcc_id() { return (unsigned)__builtin_amdgcn_s_getreg((3 << 11) | 20) & 0xFu; }
DI int tile_count(const BlkMap& bm, int Mt, int Nt) { return bm.ok ? (Mt * Nt) >> 3 : Mt * Nt; }
DI int tile_first(const BlkMap& bm) { return bm.ok ? bm.rank : (int)blockIdx.x; }
DI int tile_step(const BlkMap& bm) { return bm.ok ? bm.cnt : (int)gridDim.x; }
DI void tile_map(const BlkMap& bm, int j, int Mt, int Nt, int& mt, int& nt) {
    if (bm.ok) {
        const int slot = j & 31, sid = (j >> 5) * 8 + bm.xcd, snn = Nt >> 2;
        const int sm = sid / snn, sn = sid % snn;
        mt = 8 * sm + (slot >> 2); nt = 4 * sn + (slot & 3);
    } else { mt = j / Nt; nt = j % Nt; }
}

constexpr int WST = 144;
constexpr int WST_BYTES = 128 * WST;
DI void stg_put(char* wl, int lrow, int lcol, const f32x4& v) { *(u32x2*)(wl + lrow * WST + lcol * 2) = (u32x2){pk_bf16(v[0], v[1]), pk_bf16(v[2], v[3])}; }
DI void stg_flush(char* wl, bf16_t* dst, size_t ld, int lane, int ncols = 64) {
    asm volatile("" : "+v"(lane) :: "memory");
    const int rr = lane >> 3, ch = lane & 7;
#pragma unroll 4
    for (int j = 0; j < 16; ++j) {
        const int row = 8 * j + rr;
        const u32x4 w = *(const u32x4*)(wl + row * WST + ch * 16);
        if (ch * 8 < ncols) *(u32x4*)(dst + (size_t)row * ld + ch * 8) = w;
    }
    asm volatile("" ::: "memory");
}
DI void st4(bf16_t* dst, const f32x4& v) { *(u32x2*)dst = (u32x2){pk_bf16(v[0], v[1]), pk_bf16(v[2], v[3])}; }

DI void phase_inproj(const Params& P, char* smem, const BlkMap& bm) {
    char* ws = P.ws;
    const bf16_t* xb = (const bf16_t*)(ws + OFF_XB); const bf16_t* wt = (const bf16_t*)(ws + OFF_WTIN);
    const float* rinv1 = (const float*)(ws + OFF_RINV1);
    const float* cosA = (const float*)(ws + OFF_COSA); const float* sinA = (const float*)(ws + OFF_SINA);
    const float* cosB = (const float*)(ws + OFF_COSB); const float* sinB = (const float*)(ws + OFF_SINB);
    bf16_t* qa = (bf16_t*)(ws + OFF_QA); bf16_t* ka = (bf16_t*)(ws + OFF_KA); bf16_t* vaT = (bf16_t*)(ws + OFF_VAT);
    bf16_t* cq = (bf16_t*)(ws + OFF_CQ); bf16_t* ckv = (bf16_t*)(ws + OFF_CKV); bf16_t* kpe = (bf16_t*)(ws + OFF_KPE);
    bf16_t* ga = (bf16_t*)(ws + OFF_GA); bf16_t* gb = (bf16_t*)(ws + OFF_GB);
    const int tid = tid_fresh(), lane = tid & 63, wid = __builtin_amdgcn_readfirstlane(tid >> 6), wr = wid >> 2, wc = wid & 3, q4 = lane >> 4;
    constexpr int Mt = T / 256, Nt = 16;
    for (int v = tile_first(bm); v < tile_count(bm, Mt, Nt); v += tile_step(bm)) {
        int mt, nt; tile_map(bm, v, Mt, Nt, mt, nt);
        const int row0 = mt * 256, col0 = nt * 256;
        f32x4 acc[8][4];
        gemm_main<true>(xb + (size_t)row0 * XB_LD, XB_LD, wt + (size_t)col0 * DM, DM, DM, smem, acc);
        const int cb = col0 + 64 * wc;
        char* wl = smem + wid * WST_BYTES;
        const size_t tw0 = (size_t)row0 + 128 * wr;
        const int lr0 = lane & 15;
        if (cb < 1024) {
            const bool isq = cb < 512;
#pragma unroll
            for (int m = 0; m < 8; ++m) {
                const size_t t = tw0 + 16 * m + lr0;
                const float sc = isq ? rinv1[t] * QS_A : rinv1[t];
#pragma unroll
                for (int n = 0; n < 2; ++n) {
                    const f32x4 c = *(const f32x4*)(cosA + t * 32 + 16 * n + 4 * q4), s = *(const f32x4*)(sinA + t * 32 + 16 * n + 4 * q4);
                    const f32x4 x1 = acc[m][n] * sc, x2 = acc[m][n + 2] * sc;
                    stg_put(wl, 16 * m + lr0, 16 * n + 4 * q4, x1 * c - x2 * s);
                    stg_put(wl, 16 * m + lr0, 32 + 16 * n + 4 * q4, x2 * c + x1 * s);
                }
                asm volatile("" ::: "memory");
            }
            stg_flush(wl, (isq ? qa : ka) + tw0 * 512 + (cb & 511), 512, lane);
        } else if (cb < 1536) {
            const int h = (cb - 1024) >> 6;
#pragma unroll
            for (int m = 0; m < 8; ++m) {
                const int t = (int)tw0 + 16 * m + lr0;
                const float r = rinv1[t];
                const int b = t >> 12, s = t & 4095;
                bf16_t* dst = vaT + ((size_t)(b * 8 + h) * 64 + 4 * q4) * SEQ + s;
#pragma unroll
                for (int n = 0; n < 4; ++n)
#pragma unroll
                    for (int i = 0; i < 4; ++i) dst[(size_t)(16 * n + i) * SEQ] = f2bf(acc[m][n][i] * r);
            }
        } else if (cb < 1920) {
#pragma unroll
            for (int m = 0; m < 8; ++m) {
                const float r = rinv1[tw0 + 16 * m + lr0];
#pragma unroll
                for (int n = 0; n < 4; ++n) stg_put(wl, 16 * m + lr0, 16 * n + 4 * q4, acc[m][n] * r);
                asm volatile("" ::: "memory");
            }
            if (cb < 1792) stg_flush(wl, cq + tw0 * 256 + (cb - 1536), 256, lane);
            else stg_flush(wl, ckv + tw0 * 128 + (cb - 1792), 128, lane);
        } else if (cb < 3968) {
#pragma unroll
            for (int m = 0; m < 8; ++m) {
                const float r = rinv1[tw0 + 16 * m + lr0];
#pragma unroll
                for (int n = 0; n < 4; ++n) {
                    f32x4 z = acc[m][n] * r, o;
#pragma unroll
                    for (int i = 0; i < 4; ++i) o[i] = __builtin_amdgcn_rcpf(1.0f + __expf(-z[i]));
                    stg_put(wl, 16 * m + lr0, 16 * n + 4 * q4, o);
                }
                asm volatile("" ::: "memory");
            }
            stg_flush(wl, (cb < 2944 ? ga + tw0 * 1024 + (cb - 1920) : gb + tw0 * 1024 + (cb - 2944)), 1024, lane);
        } else if (cb == 3968) {
#pragma unroll
            for (int m = 0; m < 8; ++m) {
                const size_t t = tw0 + 16 * m + lr0;
                const float r = rinv1[t];
                const f32x4 c = *(const f32x4*)(cosB + t * 16 + 4 * q4), s = *(const f32x4*)(sinB + t * 16 + 4 * q4);
                const f32x4 x1 = acc[m][0] * r, x2 = acc[m][1] * r;
                stg_put(wl, 16 * m + lr0, 4 * q4, x1 * c - x2 * s);
                stg_put(wl, 16 * m + lr0, 16 + 4 * q4, x2 * c + x1 * s);
                asm volatile("" ::: "memory");
            }
            stg_flush(wl, kpe + tw0 * 32, 32, lane, 32);
        }
    }
}

DI void row_rinv256(const bf16_t* __restrict__ A, int lda, int K, float* s_rinv) {
    const int tid = tid_fresh(), row = tid >> 1, hf = tid & 1;
    const u32x4* p = (const u32x4*)(A + (size_t)row * lda + hf * (K / 2));
    float ss = 0.f;
    for (int c = 0; c < K / 16; ++c) {
        const u32x4 w = p[c];
#pragma unroll
        for (int j = 0; j < 4; ++j) { const float a = bf_lo(w[j]), b = bf_hi(w[j]); ss += a * a + b * b; }
    }
    ss += __shfl_xor(ss, 1);
    if (!hf) s_rinv[row] = rsqrtf(ss / (float)K + RMS_EPS);
}

DI void phase_mla_up(const Params& P, char* smem) {
    char* ws = P.ws;
    const bf16_t* cq = (const bf16_t*)(ws + OFF_CQ); const bf16_t* ckv = (const bf16_t*)(ws + OFF_CKV);
    const bf16_t* wq = (const bf16_t*)(ws + OFF_WTQUP); const bf16_t* wkv = (const bf16_t*)(ws + OFF_WTKVUP);
    const float* cosB = (const float*)(ws + OFF_COSB); const float* sinB = (const float*)(ws + OFF_SINB);
    bf16_t* qn = (bf16_t*)(ws + OFF_QN); bf16_t* qpe = (bf16_t*)(ws + OFF_QPE); bf16_t* kn = (bf16_t*)(ws + OFF_KN); bf16_t* vbT = (bf16_t*)(ws + OFF_VBT);
    const bf16_t* ka = (const bf16_t*)(ws + OFF_KA); float* kmean = (float*)(ws + OFF_KMEAN);
    float* s_rinv = (float*)(smem + 2 * GEMM_LDS);
    char* wl = smem + (threadIdx.x >> 6) * WST_BYTES;
    const int tid = tid_fresh(), lane = tid & 63, wid = __builtin_amdgcn_readfirstlane(tid >> 6), wr = wid >> 2, wc = wid & 3, q4 = lane >> 4;
    constexpr int Mt = T / 256;
    constexpr int N_Q = Mt * 3, N_KV = Mt * 4, N_KM = 128;
    for (int v = blockIdx.x; v < N_Q; v += gridDim.x) {
        __syncthreads();
        {
            const int mt = v / 3, nt = v % 3, row0 = mt * 256, col0 = nt * 256;
            row_rinv256(cq + (size_t)row0 * 256, 256, 256, s_rinv);
            f32x4 acc[8][4];
            gemm_main<true>(cq + (size_t)row0 * 256, 256, wq + (size_t)col0 * 256, 256, 256, smem, acc);
            const int cb = col0 + 64 * wc;
#pragma unroll
            for (int m = 0; m < 8; ++m) {
                const int lr = 128 * wr + 16 * m + (lane & 15), t = row0 + lr;
                const float r = s_rinv[lr] * QS_B;
                if (cb < 512) {
#pragma unroll
                    for (int n = 0; n < 4; ++n) stg_put(wl, lr - 128 * wr, 16 * n + 4 * q4, acc[m][n] * r);
                } else {
                    const f32x4 c = *(const f32x4*)(cosB + (size_t)t * 16 + 4 * q4), s = *(const f32x4*)(sinB + (size_t)t * 16 + 4 * q4);
#pragma unroll
                    for (int pr = 0; pr < 2; ++pr) {
                        const f32x4 x1 = acc[m][2 * pr] * r, x2 = acc[m][2 * pr + 1] * r;
                        stg_put(wl, lr - 128 * wr, 32 * pr + 4 * q4, x1 * c - x2 * s);
                        stg_put(wl, lr - 128 * wr, 32 * pr + 16 + 4 * q4, x2 * c + x1 * s);
                    }
                }
            }
            if (cb < 512) stg_flush(wl, qn + ((size_t)row0 + 128 * wr) * 512 + cb, 512, lane);
            else stg_flush(wl, qpe + ((size_t)row0 + 128 * wr) * 256 + (cb - 512), 256, lane);
        }
    }
    for (int v = N_Q + blockIdx.x; v < N_Q + N_KV; v += gridDim.x) {
        __syncthreads();
        {
            const int u = v - N_Q, mt = u >> 2, nt = u & 3, row0 = mt * 256, col0 = nt * 256;
            row_rinv256(ckv + (size_t)row0 * 128, 128, 128, s_rinv);
            f32x4 acc[8][4];
            gemm_main<true>(ckv + (size_t)row0 * 128, 128, wkv + (size_t)col0 * 128, 128, 128, smem, acc);
            const int cb = col0 + 64 * wc;
#pragma unroll
            for (int m = 0; m < 8; ++m) {
                const int lr = 128 * wr + 16 * m + (lane & 15), t = row0 + lr;
                const float r = s_rinv[lr];
                if (cb < 512) {
#pragma unroll
                    for (int n = 0; n < 4; ++n) stg_put(wl, lr - 128 * wr, 16 * n + 4 * q4, acc[m][n] * r);
                } else {
                    const int h = (cb - 512) >> 6, b = t >> 12, s = t & 4095;
                    bf16_t* dst = vbT + ((size_t)(b * 8 + h) * 64 + 4 * q4) * SEQ + s;
#pragma unroll
                    for (int n = 0; n < 4; ++n)
#pragma unroll
                        for (int i = 0; i < 4; ++i) dst[(size_t)(16 * n + i) * SEQ] = f2bf(acc[m][n][i] * r);
                }
            }
            if (cb < 512) stg_flush(wl, kn + ((size_t)row0 + 128 * wr) * 512 + cb, 512, lane);
        }
    }
    for (int v = N_Q + N_KV + (int)((blockIdx.x + (gridDim.x >> 1)) % gridDim.x); v < N_Q + N_KV + N_KM; v += gridDim.x) {
        {
            const int u = v - N_Q - N_KV, b = u >> 4, blk = u & 15;
            if (tid < 256) {
                const unsigned* src = (const unsigned*)(ka + ((size_t)b * SEQ + blk * 256) * 512) + tid;
                float s0 = 0.f, s1 = 0.f;
                for (int rr = 0; rr < 256; ++rr) { const unsigned w = src[(size_t)rr * 256]; s0 += bf_lo(w); s1 += bf_hi(w); }
                const int c = 2 * tid, h = c >> 6, d = c & 63;
                float* dst = kmean + ((size_t)((b * 8 + h) * 16 + blk)) * 64 + d;
                dst[0] = s0 * (1.0f / 256.0f); dst[1] = s1 * (1.0f / 256.0f);
            }
        }
    }
}

constexpr int NSUB = 4, KVT = 32 * NSUB;
constexpr int VSTR = KVT + 4;
constexpr int ATT_V_OFF = 2 * KVT * 104 * 2;
constexpr int ATT_ITEM_OFF = ATT_V_OFF + 2 * 64 * VSTR * 2;
template <bool MOBA>
DI void attn_item(const Params& P, int bh, int qt, char* smem) {
    constexpr int DK = MOBA ? 64 : 96, KS = DK / 16, KSTR = DK + 8;
    char* ws = P.ws;
    bf16_t* Ks = (bf16_t*)smem; bf16_t* Vs = (bf16_t*)(smem + ATT_V_OFF);
    const int tid = tid_fresh(), lane = tid & 63, w = __builtin_amdgcn_readfirstlane(tid >> 6), ql = lane & 31, hh = lane >> 5;
    const int b = bh >> 3, h = bh & 7, s0 = qt * 256, sq = s0 + 32 * w + ql;
    const size_t tq = (size_t)b * SEQ + sq;
    const bf16_t* Kg = (const bf16_t*)(ws + (MOBA ? OFF_KA : OFF_KN));
    const bf16_t* kpe = (const bf16_t*)(ws + OFF_KPE);
    const bf16_t* vT = (const bf16_t*)(ws + (MOBA ? OFF_VAT : OFF_VBT)) + (size_t)bh * 64 * SEQ;
    bf16x8 qf[KS];
    if (MOBA) {
        const bf16_t* qa = (const bf16_t*)(ws + OFF_QA) + tq * 512 + h * 64 + 8 * hh;
#pragma unroll
        for (int ks = 0; ks < 4; ++ks) qf[ks] = *(const bf16x8*)(qa + 16 * ks);
    } else {
        const bf16_t* qn = (const bf16_t*)(ws + OFF_QN) + tq * 512 + h * 64 + 8 * hh;
        const bf16_t* qp = (const bf16_t*)(ws + OFF_QPE) + tq * 256 + h * 32 + 8 * hh;
#pragma unroll
        for (int ks = 0; ks < 4; ++ks) qf[ks] = *(const bf16x8*)(qn + 16 * ks);
#pragma unroll
        for (int ks = 4; ks < KS; ++ks) qf[ks] = *(const bf16x8*)(qp + 16 * (ks - 4));
    }
    unsigned selmask = 0xffffffffu;
    if (MOBA) {
        const int blk = qt;
        float qv[32];
#pragma unroll
        for (int ks = 0; ks < 4; ++ks) {
            const u32x4 wq = __builtin_bit_cast(u32x4, qf[ks]);
#pragma unroll
            for (int j = 0; j < 4; ++j) { qv[8 * ks + 2 * j] = bf_lo(wq[j]); qv[8 * ks + 2 * j + 1] = bf_hi(wq[j]); }
        }
        const float* km = (const float*)(ws + OFF_KMEAN) + (size_t)bh * 16 * 64 + 8 * hh;
        float g[16];
#pragma unroll
        for (int n = 0; n < 16; ++n) {
            float a = -INFINITY;
            if (n < blk) {
                a = 0.f;
#pragma unroll
                for (int ks = 0; ks < 4; ++ks) {
                    const f32x4 k0 = *(const f32x4*)(km + n * 64 + 16 * ks), k1 = *(const f32x4*)(km + n * 64 + 16 * ks + 4);
#pragma unroll
                    for (int j = 0; j < 4; ++j) { a += qv[8 * ks + j] * k0[j]; a += qv[8 * ks + 4 + j] * k1[j]; }
                }
                a += __shfl_xor(a, 32);
            }
            g[n] = a;
        }
        unsigned mask = 0u;
        if (blk <= 3) mask = (1u << blk) - 1u;
        else {
#pragma unroll
            for (int r = 0; r < 3; ++r) {
                float best = -INFINITY; int bi = 0;
#pragma unroll
                for (int n = 0; n < 16; ++n) if (g[n] > best) { best = g[n]; bi = n; }
                mask |= 1u << bi;
#pragma unroll
                for (int n = 0; n < 16; ++n) g[n] = (n == bi) ? -INFINITY : g[n];
            }
        }
        selmask = mask | (1u << blk);
    }
    const int krow = tid >> 3, kch = tid & 7;
    const int vd = tid >> 4, vch = tid & 15;
    const bf16_t* kp0 = Kg + ((size_t)b * SEQ + krow) * 512 + h * 64 + kch * 8;
    const bf16_t* kpp = kpe + ((size_t)b * SEQ + (tid >> 2)) * 32 + (tid & 3) * 8;
    const bf16_t* vp0 = vT + (size_t)vd * SEQ + vch * 8;
    u32x4 rk[3], rv[2];
    const int nkt = 2 * qt + 2;
#define ATT_GLOAD(kt) do { \
        rk[0] = *(const u32x4*)(kp0 + (size_t)(KVT * (kt)) * 512); rk[1] = *(const u32x4*)(kp0 + (size_t)(KVT * (kt) + 64) * 512); \
        if (!MOBA) rk[2] = *(const u32x4*)(kpp + (size_t)(KVT * (kt)) * 32); \
        rv[0] = *(const u32x4*)(vp0 + KVT * (kt)); rv[1] = *(const u32x4*)(vp0 + (size_t)32 * SEQ + KVT * (kt)); } while (0)
    ATT_GLOAD(0);
    f32x16 O[2];
#pragma unroll
    for (int i = 0; i < 16; ++i) { O[0][i] = 0.f; O[1][i] = 0.f; }
    float mrun = -INFINITY, lrun = 0.f;
    const int wq0 = s0 + 32 * w;
    for (int kt = 0; kt < nkt; ++kt) {
        bf16_t* Kb = Ks + (kt & 1) * KVT * KSTR; bf16_t* Vb = Vs + (kt & 1) * 64 * VSTR;
        *(u32x4*)(Kb + krow * KSTR + kch * 8) = rk[0];
        *(u32x4*)(Kb + (krow + 64) * KSTR + kch * 8) = rk[1];
        if (!MOBA) *(u32x4*)(Kb + (tid >> 2) * KSTR + 64 + (tid & 3) * 8) = rk[2];
        *(u32x2*)(Vb + vd * VSTR + vch * 8) = (u32x2){rv[0][0], rv[0][1]};
        *(u32x2*)(Vb + vd * VSTR + vch * 8 + 4) = (u32x2){rv[0][2], rv[0][3]};
        *(u32x2*)(Vb + (vd + 32) * VSTR + vch * 8) = (u32x2){rv[1][0], rv[1][1]};
        *(u32x2*)(Vb + (vd + 32) * VSTR + vch * 8 + 4) = (u32x2){rv[1][2], rv[1][3]};
        __syncthreads();
        if (kt + 1 < nkt) ATT_GLOAD(kt + 1);
        const int kbase = KVT * kt;
        if (kbase <= wq0 + 31) {
            f32x16 Sv[NSUB];
#pragma unroll
            for (int sub = 0; sub < NSUB; ++sub) {
#pragma unroll
                for (int i = 0; i < 16; ++i) Sv[sub][i] = 0.f;
#pragma unroll
                for (int ks = 0; ks < KS; ++ks) {
                    const bf16x8 kf = *(const bf16x8*)(Kb + (32 * sub + ql) * KSTR + 16 * ks + 8 * hh);
                    Sv[sub] = MFMA32(kf, qf[ks], Sv[sub]);
                }
            }
            if (kbase + KVT - 1 > wq0) {
#pragma unroll
                for (int sub = 0; sub < NSUB; ++sub) {
                    const int thr = sq - kbase - 32 * sub - 4 * hh;
#pragma unroll
                    for (int i = 0; i < 16; ++i) if (((i & 3) + 8 * (i >> 2)) > thr) Sv[sub][i] = -INFINITY;
                }
            }
            float mt = -INFINITY;
#pragma unroll
            for (int i = 0; i < 16; ++i) mt = fmaxf(fmaxf(mt, fmaxf(Sv[0][i], Sv[1][i])), fmaxf(Sv[2][i], Sv[3][i]));
            mt = fmaxf(mt, __shfl_xor(mt, 32));
            bool sel = true;
            if (MOBA) { sel = (selmask >> (kbase >> 8)) & 1u; if (!sel) mt = -INFINITY; }
            const bool need = mt > mrun + 8.0f;
            if (__builtin_amdgcn_ballot_w64(need) != 0ull) {
                const float mnew = fmaxf(mrun, mt);
                const float ms = (mnew == -INFINITY) ? 0.f : mnew;
                const float alpha = __builtin_amdgcn_exp2f(mrun - ms);
                lrun *= alpha; mrun = mnew;
#pragma unroll
                for (int i = 0; i < 16; ++i) { O[0][i] *= alpha; O[1][i] *= alpha; }
            }
            const float msafe = (mrun == -INFINITY) ? 0.f : mrun;
            const float msub = sel ? msafe : INFINITY;
            float psum = 0.f;
#pragma unroll
            for (int sub = 0; sub < NSUB; ++sub)
#pragma unroll
                for (int i = 0; i < 16; ++i) { const float pv = __builtin_amdgcn_exp2f(Sv[sub][i] - msub); Sv[sub][i] = pv; psum += pv; }
            lrun += psum;
#pragma unroll
            for (int sub = 0; sub < NSUB; ++sub)
#pragma unroll
                for (int s = 0; s < 2; ++s) {
                    u32x4 pw;
#pragma unroll
                    for (int j = 0; j < 4; ++j) pw[j] = pk_bf16(Sv[sub][8 * s + 2 * j], Sv[sub][8 * s + 2 * j + 1]);
                    const bf16x8 pf = __builtin_bit_cast(bf16x8, pw);
#pragma unroll
                    for (int dt = 0; dt < 2; ++dt) {
                        const bf16_t* vrow = Vb + (32 * dt + ql) * VSTR + 32 * sub + 16 * s + 4 * hh;
                        const u32x2 v0 = *(const u32x2*)vrow, v1 = *(const u32x2*)(vrow + 8);
                        const bf16x8 vf = __builtin_bit_cast(bf16x8, (u32x4){v0[0], v0[1], v1[0], v1[1]});
                        O[dt] = MFMA32(vf, pf, O[dt]);
                    }
                }
        }
    }
#undef ATT_GLOAD
    lrun += __shfl_xor(lrun, 32);
    const float inv = 1.0f / lrun;
    bf16_t* y = (bf16_t*)(ws + (MOBA ? OFF_YA : OFF_YB)) + tq * 512 + h * 64 + 4 * hh;
#pragma unroll
    for (int dt = 0; dt < 2; ++dt)
#pragma unroll
        for (int g = 0; g < 4; ++g)
            *(u32x2*)(y + 32 * dt + 8 * g) = (u32x2){pk_bf16(O[dt][4 * g] * inv, O[dt][4 * g + 1] * inv), pk_bf16(O[dt][4 * g + 2] * inv, O[dt][4 * g + 3] * inv)};
}

DI void phase_attn(const Params& P, char* smem, int ci = 0) {
    unsigned* ctr = (unsigned*)(P.ws + OFF_CTR) + ci;
    int* s_item = (int*)(smem + ATT_ITEM_OFF);
    for (;;) {
        __syncthreads();
        if (threadIdx.x == 0) *s_item = (int)atomicAdd(ctr, 1u);
        __syncthreads();
        const int item = *s_item;
        if (item >= 2048) break;
        const int qt = 15 - (item >> 7), rest = item & 127, bh = rest & 63;
        if (rest < 64) attn_item<false>(P, bh, qt, smem); else attn_item<true>(P, bh, qt, smem);
    }
}

DI void phase_merge(const Params& P, char* smem, const BlkMap& bm) {
    char* ws = P.ws;
    const bf16_t* ya = (const bf16_t*)(ws + OFF_YA); const bf16_t* yb = (const bf16_t*)(ws + OFF_YB);
    const bf16_t* wa = (const bf16_t*)(ws + OFF_WTA); const bf16_t* wb = (const bf16_t*)(ws + OFF_WTB);
    const bf16_t* ga = (const bf16_t*)(ws + OFF_GA); const bf16_t* gb = (const bf16_t*)(ws + OFF_GB);
    bf16_t* merged = (bf16_t*)(ws + OFF_MERGED);
    const int tid = tid_fresh(), lane = tid & 63, wid = __builtin_amdgcn_readfirstlane(tid >> 6), wr = wid >> 2, wc = wid & 3, q4 = lane >> 4;
    char* wl = smem + wid * WST_BYTES;
    constexpr int Mt = T / 256, Nt = 4;
    for (int v = tile_first(bm); v < tile_count(bm, Mt, Nt); v += tile_step(bm)) {
        int mt, nt; tile_map(bm, v, Mt, Nt, mt, nt);
        const int row0 = mt * 256, col0 = nt * 256;
        f32x4 acc[8][4];
        gemm_main<true>(ya + (size_t)row0 * 512, 512, wa + (size_t)col0 * 512, 512, 512, smem, acc);
#pragma unroll
        for (int m = 0; m < 8; ++m) {
            const size_t t = row0 + 128 * wr + 16 * m + (lane & 15);
#pragma unroll
            for (int n = 0; n < 4; ++n) {
                const int c = col0 + 64 * wc + 16 * n + 4 * q4;
                const u32x2 wa2 = *(const u32x2*)(ga + t * 1024 + c), wb2 = *(const u32x2*)(gb + t * 1024 + c);
                acc[m][n][0] *= bf_lo(wa2[0]) / fmaxf(bf_lo(wb2[0]), 1e-30f);
                acc[m][n][1] *= bf_hi(wa2[0]) / fmaxf(bf_hi(wb2[0]), 1e-30f);
                acc[m][n][2] *= bf_lo(wa2[1]) / fmaxf(bf_lo(wb2[1]), 1e-30f);
                acc[m][n][3] *= bf_hi(wa2[1]) / fmaxf(bf_hi(wb2[1]), 1e-30f);
            }
        }
        gemm_main<false>(yb + (size_t)row0 * 512, 512, wb + (size_t)col0 * 512, 512, 512, smem, acc);
#pragma unroll
        for (int m = 0; m < 8; ++m) {
            const size_t t = row0 + 128 * wr + 16 * m + (lane & 15);
#pragma unroll
            for (int n = 0; n < 4; ++n) {
                const int c = col0 + 64 * wc + 16 * n + 4 * q4;
                const u32x2 wb2 = *(const u32x2*)(gb + t * 1024 + c);
                f32x4 o;
                o[0] = fmaxf(bf_lo(wb2[0]), 1e-30f) * acc[m][n][0]; o[1] = fmaxf(bf_hi(wb2[0]), 1e-30f) * acc[m][n][1];
                o[2] = fmaxf(bf_lo(wb2[1]), 1e-30f) * acc[m][n][2]; o[3] = fmaxf(bf_hi(wb2[1]), 1e-30f) * acc[m][n][3];
                stg_put(wl, 16 * m + (lane & 15), 16 * n + 4 * q4, o);
            }
        }
        stg_flush(wl, merged + ((size_t)row0 + 128 * wr) * 1024 + col0 + 64 * wc, 1024, lane);
    }
}

DI void phase_outproj(const Params& P, char* smem, const BlkMap& bm) {
    char* ws = P.ws;
    const bf16_t* merged = (const bf16_t*)(ws + OFF_MERGED); const bf16_t* wo = (const bf16_t*)(ws + OFF_WTOUT);
    float* x2 = (float*)(ws + OFF_X2); bf16_t* x2b = (bf16_t*)(ws + OFF_X2B); float* ssq2 = (float*)(ws + OFF_SSQ2);
    const int tid = tid_fresh(), lane = tid & 63, wid = __builtin_amdgcn_readfirstlane(tid >> 6), wr = wid >> 2, wc = wid & 3, q4 = lane >> 4;
    char* wl = smem + wid * WST_BYTES;
    constexpr int Mt = T / 256, Nt = 4;
    for (int v = tile_first(bm); v < tile_count(bm, Mt, Nt); v += tile_step(bm)) {
        int mt, nt; tile_map(bm, v, Mt, Nt, mt, nt);
        const int row0 = mt * 256, col0 = nt * 256;
        f32x4 acc[8][4];
        gemm_main<true>(merged + (size_t)row0 * 1024, 1024, wo + (size_t)col0 * 1024, 1024, 1024, smem, acc);
#pragma unroll
        for (int m = 0; m < 8; ++m) {
            const size_t t = row0 + 128 * wr + 16 * m + (lane & 15);
            float ssp = 0.f;
#pragma unroll
            for (int n = 0; n < 4; ++n) {
                const int c = col0 + 64 * wc + 16 * n + 4 * q4;
                const f32x4 o = *(const f32x4*)(P.x + t * 1024 + c) + acc[m][n];
                *(f32x4*)(x2 + t * 1024 + c) = o;
                stg_put(wl, 16 * m + (lane & 15), 16 * n + 4 * q4, o);
                ssp += o[0] * o[0] + o[1] * o[1] + o[2] * o[2] + o[3] * o[3];
            }
            ssp += __shfl_xor(ssp, 16); ssp += __shfl_xor(ssp, 32);
            if (q4 == 0) atomicAdd(ssq2 + t, ssp);
        }
        stg_flush(wl, x2b + ((size_t)row0 + 128 * wr) * 1024 + col0 + 64 * wc, 1024, lane);
    }
}

DI int mono(int b) { return b ^ ((b >> 31) & 0x7fffffff); }
DI void ins16(int (&a)[16], int v) {
#pragma unroll
    for (int s = 0; s < 16; ++s) { const int t = max(a[s], v); v = min(a[s], v); a[s] = t; }
}
DI void cex(int& hi, int& lo) { const int a = max(hi, lo), b = min(hi, lo); hi = a; lo = b; }
DI void bitonic_merge16(int (&a)[16]) {
#pragma unroll
    for (int j = 8; j > 0; j >>= 1)
#pragma unroll
        for (int i = 0; i < 16; ++i) { const int l = i ^ j; if (l > i) cex(a[i], a[l]); }
}
DI void bitonic_sort16(int (&a)[16]) {
#pragma unroll
    for (int k = 2; k <= 16; k <<= 1)
#pragma unroll
        for (int j = k >> 1; j > 0; j >>= 1)
#pragma unroll
            for (int i = 0; i < 16; ++i) { const int l = i ^ j; if (l > i) { if ((i & k) == 0) cex(a[i], a[l]); else cex(a[l], a[i]); } }
}
DI void merge_top16(int (&x)[16], const int (&y)[16]) {
#pragma unroll
    for (int i = 0; i < 16; ++i) x[i] = max(x[i], y[15 - i]);
    bitonic_merge16(x);
}
DI float rinv2_of(const float* ssq2, size_t t) { return rsqrtf(ssq2[t] * (1.0f / DM) + RMS_EPS); }
DI void peer_topk_task(const Params& P, const bf16_t* qrow, size_t t, int h, unsigned* lw, int ql, int hh) {
    char* ws = P.ws;
    const bf16_t* keysb = (const bf16_t*)(ws + OFF_KEYS);
    int* pidx = (int*)(ws + OFF_PIDX); float* pg = (float*)(ws + OFF_PG);
    int a[2][16];
#pragma unroll
    for (int half = 0; half < 2; ++half) {
        bf16x8 qf[8];
#pragma unroll
        for (int ks = 0; ks < 8; ++ks) qf[ks] = *(const bf16x8*)(qrow + half * 128 + 16 * ks + 8 * hh);
        const bf16_t* kb = keysb + (size_t)((half * 8 + h) * 128) * 128 + 8 * hh;
#pragma unroll
        for (int nt = 0; nt < 4; ++nt) {
            f32x16 acc;
#pragma unroll
            for (int i = 0; i < 16; ++i) acc[i] = 0.f;
#pragma unroll
            for (int ks = 0; ks < 8; ++ks) {
                const bf16x8 kf = *(const bf16x8*)(kb + (size_t)(32 * nt + ql) * 128 + 16 * ks);
                acc = MFMA32(kf, qf[ks], acc);
            }
            int kk[16];
#pragma unroll
            for (int i = 0; i < 16; ++i) {
                const int n = 32 * nt + (i & 3) + 8 * (i >> 2) + 4 * hh;
                kk[i] = (mono(__float_as_int(acc[i])) & ~127) | (127 - n);
            }
            bitonic_sort16(kk);
            if (nt == 0) {
#pragma unroll
                for (int s = 0; s < 16; ++s) a[half][s] = kk[s];
            } else merge_top16(a[half], kk);
        }
        int pa[16];
#pragma unroll
        for (int s = 0; s < 16; ++s) pa[s] = __shfl_xor(a[half][s], 32);
        merge_top16(a[half], pa);
    }
    float f1[16], f2[16];
#pragma unroll
    for (int i = 0; i < 16; ++i) { f1[i] = __int_as_float(mono(a[0][i] & ~127)); f2[i] = __int_as_float(mono(a[1][i] & ~127)); }
#pragma unroll
    for (int k = 0; k < 4; ++k) {
        unsigned w1 = 0u, w2 = 0u;
#pragma unroll
        for (int j = 0; j < 4; ++j) { w1 |= (unsigned)(127 - (a[0][4 * k + j] & 127)) << (8 * j); w2 |= (unsigned)(127 - (a[1][4 * k + j] & 127)) << (8 * j); }
        lw[k] = w1; lw[4 + k] = w2;
    }
    int bb[16];
#pragma unroll
    for (int s = 0; s < 16; ++s) bb[s] = (int)0x80000000;
#pragma unroll
    for (int i = 0; i < 16; ++i)
#pragma unroll
        for (int j = 0; j < 16; ++j)
            if ((i + 1) * (j + 1) <= 16) {
                const float c = f1[i] + f2[j];
                const int key = (mono(__float_as_int(c)) & ~255) | (i << 4) | j;
                ins16(bb, key);
            }
    const float r2 = rinv2_of((const float*)(ws + OFF_SSQ2), t);
    float z[16], e[16], sum = 0.f;
#pragma unroll
    for (int r = 0; r < 16; ++r) z[r] = __int_as_float(mono(bb[r] & ~255)) * r2;
#pragma unroll
    for (int r = 0; r < 16; ++r) { e[r] = __expf(z[r] - z[0]); sum += e[r]; }
    const float inv = 1.0f / sum;
    if (hh == 0) {
        int id[16];
#pragma unroll
        for (int r = 0; r < 16; ++r) {
            const int cid = bb[r] & 255, i = cid >> 4, j = cid & 15;
            const unsigned w1 = lw[i >> 2], w2 = lw[4 + (j >> 2)];
            const int n1 = (w1 >> (8 * (i & 3))) & 255, n2 = (w2 >> (8 * (j & 3))) & 255;
            id[r] = n1 * 128 + n2;
        }
        int* di = pidx + t * 128 + h * 16; float* dg = pg + t * 128 + h * 16;
#pragma unroll
        for (int k = 0; k < 4; ++k) {
            *(u32x4*)(di + 4 * k) = (u32x4){(unsigned)id[4 * k], (unsigned)id[4 * k + 1], (unsigned)id[4 * k + 2], (unsigned)id[4 * k + 3]};
            *(f32x4*)(dg + 4 * k) = (f32x4){e[4 * k] * inv, e[4 * k + 1] * inv, e[4 * k + 2] * inv, e[4 * k + 3] * inv};
        }
        unsigned* d16 = (unsigned*)(ws + OFF_PIDX16) + t * 64 + h * 8;
#pragma unroll
        for (int k = 0; k < 2; ++k)
            *(u32x4*)(d16 + 4 * k) = (u32x4){(unsigned)id[8 * k] | ((unsigned)id[8 * k + 1] << 16), (unsigned)id[8 * k + 2] | ((unsigned)id[8 * k + 3] << 16),
                                              (unsigned)id[8 * k + 4] | ((unsigned)id[8 * k + 5] << 16), (unsigned)id[8 * k + 6] | ((unsigned)id[8 * k + 7] << 16)};
    }
}

DI void phase_peerq(const Params& P, char* smem, const BlkMap& bm) {
    char* ws = P.ws;
    const int tid = tid_fresh(), lane = tid & 63, wid = __builtin_amdgcn_readfirstlane(tid >> 6), wr = wid >> 2, wc = wid & 3, q4 = lane >> 4;
    const int gw = blockIdx.x * NWV + wid, nw = gridDim.x * NWV;
    const int gt = blockIdx.x * NTHR + tid, ntd = gridDim.x * NTHR;
    {
        unsigned* ub = (unsigned*)(ws + OFF_UB); unsigned* vb = (unsigned*)(ws + OFF_VB8);
        for (int idx = gt; idx < 16384 * 1024 / 16; idx += ntd) {
            const size_t e = (size_t)idx * 16; const int c = (int)(e & 1023);
            u32x4 uo, vo;
#pragma unroll
            for (int q = 0; q < 4; ++q) {
                const f32x4 g0 = *(const f32x4*)(P.ffn_g + c + 4 * q) * U8_SCALE;
                const f32x4 u0 = *(const f32x4*)(P.eu + e + 4 * q) * g0;
                const f32x4 v0 = *(const f32x4*)(P.ev + e + 4 * q) * V8_SCALE;
                uo[q] = pack_fp8x4(u0[0], u0[1], u0[2], u0[3]);
                vo[q] = pack_fp8x4(v0[0], v0[1], v0[2], v0[3]);
            }
            *(u32x4*)(ub + e / 4) = uo;
            *(u32x4*)(vb + e / 4) = vo;
        }
    }
    const bf16_t* x2b = (const bf16_t*)(ws + OFF_X2B); const bf16_t* wp = (const bf16_t*)(ws + OFF_WTPQ);
    constexpr int QIMG_STR = 528, QIMG_BYTES = 256 * QIMG_STR;
    constexpr int Mt = T / 256, Nt = 8;
    for (int v = tile_first(bm); v < tile_count(bm, Mt, Nt); v += tile_step(bm)) {
        int mt, nt; tile_map(bm, v, Mt, Nt, mt, nt);
        const int row0 = mt * 256, col0 = nt * 256;
        f32x4 acc[8][4];
        gemm_main<true>(x2b + (size_t)row0 * 1024, 1024, wp + (size_t)col0 * 1024, 1024, 1024, smem, acc);
        int lz = lane; asm volatile("" : "+v"(lz));
#pragma unroll
        for (int m = 0; m < 8; ++m) {
#pragma unroll
            for (int n = 0; n < 4; ++n) {
                const f32x4 v4 = acc[m][n];
                *(u32x2*)(smem + (128 * wr + 16 * m + (lz & 15)) * QIMG_STR + (64 * wc + 16 * n + 4 * (lz >> 4)) * 2) = (u32x2){pk_bf16(v4[0], v4[1]), pk_bf16(v4[2], v4[3])};
            }
        }
        __syncthreads();
        peer_topk_task(P, (const bf16_t*)(smem + (32 * wid + (lz & 31)) * QIMG_STR), (size_t)row0 + 32 * wid + (lz & 31), nt,
                       (unsigned*)(smem + QIMG_BYTES) + wid * 512 + lz * 8, lz & 31, lz >> 5);
    }
}

DI float reduce16(float (&p)[16], int lane) {
    const bool b5 = lane & 32, b4 = lane & 16, b3 = lane & 8, b2 = lane & 4;
    float r8[8], r4[4], r2[2];
#pragma unroll
    for (int i = 0; i < 8; ++i) { const float keep = b5 ? p[i + 8] : p[i], send = b5 ? p[i] : p[i + 8]; r8[i] = keep + __shfl_xor(send, 32); }
#pragma unroll
    for (int i = 0; i < 4; ++i) { const float keep = b4 ? r8[i + 4] : r8[i], send = b4 ? r8[i] : r8[i + 4]; r4[i] = keep + __shfl_xor(send, 16); }
#pragma unroll
    for (int i = 0; i < 2; ++i) { const float keep = b3 ? r4[i + 2] : r4[i], send = b3 ? r4[i] : r4[i + 2]; r2[i] = keep + __shfl_xor(send, 8); }
    const float keep = b2 ? r2[1] : r2[0], send = b2 ? r2[0] : r2[1];
    float r1 = keep + __shfl_xor(send, 4);
    r1 += __shfl_xor(r1, 2); r1 += __shfl_xor(r1, 1);
    return r1;
}
constexpr size_t OFF_PART = R1;
constexpr size_t OFF_SSQ = OFF_COSA;
DI bool slice_next(const BlkMap& bm, int it, int wid, int& t, int& x) {
    if (bm.ok) { t = bm.rank * NWV + wid + it * (32 * NWV); x = bm.xcd; return t < T; }
    const int p = (int)blockIdx.x * NWV + wid + it * (int)gridDim.x * NWV; t = p >> 3; x = p & 7; return p < T * 8;
}
DI void phase_exp_u(const Params& P, const BlkMap& bm) {
    char* ws = P.ws;
    const bf16_t* x2b = (const bf16_t*)(ws + OFF_X2B);
    const unsigned char* ub = (const unsigned char*)(ws + OFF_UB);
    const int* pidx = (const int*)(ws + OFF_PIDX);
    float* part = (float*)(ws + OFF_PART);
    const int tid = tid_fresh(), lane = tid & 63, wid = __builtin_amdgcn_readfirstlane(tid >> 6), g = lane >> 3, r = lane & 7;
    int t, x;
    for (int it = 0; slice_next(bm, it, wid, t, x); ++it) {
        f32x2 xv[8];
        {
            const bf16_t* xp = x2b + (size_t)t * 1024 + 128 * x + 16 * r;
            const u32x4 a = *(const u32x4*)xp, b = *(const u32x4*)(xp + 8);
#pragma unroll
            for (int j = 0; j < 4; ++j) { xv[j] = (f32x2){bf_lo(a[j]), bf_hi(a[j])}; xv[4 + j] = (f32x2){bf_lo(b[j]), bf_hi(b[j])}; }
        }
        int id[16];
#pragma unroll
        for (int q = 0; q < 2; ++q) {
            const u32x4 w = *(const u32x4*)((const unsigned*)(ws + OFF_PIDX16) + (size_t)t * 64 + g * 8 + 4 * q);
#pragma unroll
            for (int c = 0; c < 4; ++c) { id[8 * q + 2 * c] = (int)(w[c] & 0xffffu); id[8 * q + 2 * c + 1] = (int)(w[c] >> 16); }
        }
        u32x4 uu[16];
        const unsigned char* ubase = ub + 128 * x + 16 * r;
#pragma unroll
        for (int j = 0; j < 16; ++j) uu[j] = *(const u32x4*)(ubase + (size_t)id[j] * 1024);
        float p[16];
#pragma unroll
        for (int j = 0; j < 16; ++j) {
            f32x2 acc = {0.f, 0.f};
#pragma unroll
            for (int q = 0; q < 4; ++q) { acc = __builtin_elementwise_fma(fp8lo(uu[j][q]), xv[2 * q], acc); acc = __builtin_elementwise_fma(fp8hi(uu[j][q]), xv[2 * q + 1], acc); }
            p[j] = acc.x + acc.y;
        }
        const bool b4 = r & 4, b2 = r & 2, b1 = r & 1;
        float q8[8], q4v[4], q2[2];
#pragma unroll
        for (int i = 0; i < 8; ++i) { const float keep = b4 ? p[i + 8] : p[i], send = b4 ? p[i] : p[i + 8]; q8[i] = keep + __shfl_xor(send, 4); }
#pragma unroll
        for (int i = 0; i < 4; ++i) { const float keep = b2 ? q8[i + 4] : q8[i], send = b2 ? q8[i] : q8[i + 4]; q4v[i] = keep + dpp_get<0x4E>(send); }
#pragma unroll
        for (int i = 0; i < 2; ++i) { const float keep = b1 ? q4v[i + 2] : q4v[i], send = b1 ? q4v[i] : q4v[i + 2]; q2[i] = keep + dpp_get<0xB1>(send); }
        *((unsigned*)part + ((size_t)x * T + t) * 64 + lane) = pk_bf16(q2[0], q2[1]);
    }
}
DI void phase_exp_w(const Params& P) {
    char* ws = P.ws;
    const float* ssq2 = (const float*)(ws + OFF_SSQ2);
    float* pg = (float*)(ws + OFF_PG); const unsigned* pidx = (const unsigned*)(ws + OFF_PIDX);
    const float* part = (const float*)(ws + OFF_PART);
    const int tid = tid_fresh(), lane = tid & 63, wid = __builtin_amdgcn_readfirstlane(tid >> 6);
    const int gw = blockIdx.x * NWV + wid, nw = gridDim.x * NWV;
    for (int t = gw; t < T; t += nw) {
        f32x2 tot = {0.f, 0.f};
#pragma unroll
        for (int xx = 0; xx < 8; ++xx) { const unsigned w = *((const unsigned*)part + ((size_t)xx * T + t) * 64 + lane); tot += (f32x2){bf_lo(w), bf_hi(w)}; }
        const float r2 = rinv2_of(ssq2, t) * (1.0f / U8_SCALE);
        const f32x2 gg = *(const f32x2*)(pg + (size_t)t * 128 + 2 * lane);
        const float a0 = tot.x * r2, a1 = tot.y * r2;
        const float w0 = gg.x * 0.5f * a0 * (1.0f + erff(a0 * 0.70710678118654752f)) * (1.0f / V8_SCALE);
        const float w1 = gg.y * 0.5f * a1 * (1.0f + erff(a1 * 0.70710678118654752f)) * (1.0f / V8_SCALE);
        const u32x2 ids = *(const u32x2*)(pidx + (size_t)t * 128 + 2 * lane);
        *(u32x2*)(pg + (size_t)t * 128 + 2 * lane) = (u32x2){(ids[0] << 16) | (unsigned)f2bf(w0), (ids[1] << 16) | (unsigned)f2bf(w1)};
    }
}
DI void phase_exp_v(const Params& P, const BlkMap& bm, char* smem) {
    char* ws = P.ws;
    const float* x2 = (const float*)(ws + OFF_X2);
    const unsigned char* vb = (const unsigned char*)(ws + OFF_VB8);
    const float* rinv2 = (const float*)(ws + OFF_RINV2);
    const int* pidx = (const int*)(ws + OFF_PIDX); const float* pg = (const float*)(ws + OFF_PG);
    const float* part = (const float*)(ws + OFF_PART);
    float* ssq = (float*)(ws + OFF_SSQ);
    const int tid = tid_fresh(), lane = tid & 63, wid = __builtin_amdgcn_readfirstlane(tid >> 6), g = lane >> 3, r = lane & 7;
    int t, x;
    for (int it = 0; slice_next(bm, it, wid, t, x); ++it) {
        int id[16]; float wj[16];
#pragma unroll
        for (int q = 0; q < 4; ++q) {
            const u32x4 w = *(const u32x4*)((const unsigned*)pg + (size_t)t * 128 + g * 16 + 4 * q);
#pragma unroll
            for (int c = 0; c < 4; ++c) { id[4 * q + c] = (int)(w[c] >> 16); wj[4 * q + c] = __uint_as_float(w[c] << 16); }
        }
        u32x4 vv[16];
        const unsigned char* vbase = vb + 128 * x + 16 * r;
#pragma unroll
        for (int j = 0; j < 16; ++j) vv[j] = *(const u32x4*)(vbase + (size_t)id[j] * 1024);
        f32x2 out[8];
#pragma unroll
        for (int i = 0; i < 8; ++i) out[i] = (f32x2){0.f, 0.f};
#pragma unroll
        for (int j = 0; j < 16; ++j) {
            const f32x2 w2 = {wj[j], wj[j]};
#pragma unroll
            for (int q = 0; q < 4; ++q) { out[2 * q] = __builtin_elementwise_fma(fp8lo(vv[j][q]), w2, out[2 * q]); out[2 * q + 1] = __builtin_elementwise_fma(fp8hi(vv[j][q]), w2, out[2 * q + 1]); }
        }
        float o[16];
#pragma unroll
        for (int i = 0; i < 8; ++i) { o[2 * i] = out[i].x; o[2 * i + 1] = out[i].y; }
        const bool b5 = lane & 32, b4 = lane & 16, b3 = lane & 8;
        float q8[8], q4v[4], q2[2];
#pragma unroll
        for (int i = 0; i < 8; ++i) q8[i] = swap_add32(o[i], o[i + 8]);
#pragma unroll
        for (int i = 0; i < 4; ++i) q4v[i] = swap_add16(q8[i], q8[i + 4]);
#pragma unroll
        for (int i = 0; i < 2; ++i) { const float keep = b3 ? q4v[i + 2] : q4v[i], send = b3 ? q4v[i] : q4v[i + 2]; q2[i] = keep + dpp_get<0x128>(send); }
        const size_t col = (size_t)t * 1024 + 128 * x + 16 * r + 2 * g;
        const f32x2 xr = *(const f32x2*)(x2 + col);
        const float y0 = xr.x + q2[0], y1 = xr.y + q2[1];
        *(f32x2*)(P.out + col) = (f32x2){y0, y1};
    }
}
DI void phase_final_norm(const Params& P) {
    const int tid = tid_fresh(), lane = tid & 63, wid = __builtin_amdgcn_readfirstlane(tid >> 6);
    const int gw = blockIdx.x * NWV + wid, nw = gridDim.x * NWV;
    for (int t = gw; t < T; t += nw) {
        float* o = P.out + (size_t)t * 1024;
        f32x4 y[4]; float ss = 0.f;
#pragma unroll
        for (int i = 0; i < 4; ++i) { y[i] = *(const f32x4*)(o + 4 * (lane + 64 * i)); ss += y[i][0] * y[i][0] + y[i][1] * y[i][1] + y[i][2] * y[i][2] + y[i][3] * y[i][3]; }
        ss = wave_sum(ss);
        const float rinv = rsqrtf(ss * (1.0f / DM) + RMS_EPS);
#pragma unroll
        for (int i = 0; i < 4; ++i) { const int c = 4 * (lane + 64 * i); *(f32x4*)(o + c) = y[i] * rinv * *(const f32x4*)(P.fin_g + c); }
    }
}

#define XB_TMO      128
#define XB_XCNT(j)  (256  + 64 * (j))
#define XB_XSUB(j)  (1280 + 64 * (j))
#define XB_XGEN(j)  (2304 + 64 * (j))
#define XB_TOP      3328
#define XB_TOPGEN   3392
#define XCD_BAR_WORDS 3456
#define XB_SPIN_CAP (1u << 18)
#define LAS __attribute__((address_space(3)))
DI unsigned xb_ld(unsigned* p)              { return __hip_atomic_load(p, __ATOMIC_RELAXED, __HIP_MEMORY_SCOPE_AGENT); }
DI unsigned xb_add(unsigned* p, unsigned v) { return __hip_atomic_fetch_add(p, v, __ATOMIC_RELAXED, __HIP_MEMORY_SCOPE_AGENT); }
#define XB_SPIN(cond, bar) do { unsigned _sp = 0; while (cond) { __builtin_amdgcn_s_sleep(1); \
    if ((++_sp & 255u) == 0u) { if (xb_ld(&(bar)[XB_TMO])) break; if (_sp > XB_SPIN_CAP) { atomicAdd(&(bar)[XB_TMO], 1u); break; } } } } while (0)
struct XcdBarrier { unsigned* bar; unsigned x; volatile LAS unsigned* st; };
DI XcdBarrier xcd_barrier_post(unsigned* bar, volatile LAS unsigned* st) {
    XcdBarrier b; b.bar = bar; b.x = (unsigned)__builtin_amdgcn_s_getreg((3 << 11) | 20) & 0xFu; b.st = st;
    if (threadIdx.x == 0) (void)xb_add(&bar[XB_XCNT(b.x)], 1u);
    return b;
}
DI void xcd_barrier_complete(unsigned* bar, unsigned x, unsigned& nloc, unsigned& nx) {
    const unsigned G = gridDim.x * gridDim.y * gridDim.z;
    unsigned sum, cnt, mine, sp = 0u;
    for (;;) {
        sum = 0u; cnt = 0u; mine = 0u;
#pragma unroll
        for (unsigned j = 0; j < 16; ++j) { const unsigned c = xb_ld(&bar[XB_XCNT(j)]); sum += c; cnt += (c > 0u) ? 1u : 0u; mine = (j == x) ? c : mine; }
        if (sum == G) break;
        __builtin_amdgcn_s_sleep(1);
        if ((++sp & 255u) == 0u) { if (xb_ld(&bar[XB_TMO])) break; if (sp > XB_SPIN_CAP) { atomicAdd(&bar[XB_TMO], 1u); break; } }
    }
    nloc = mine > 0u ? mine : 1u; nx = cnt > 0u ? cnt : 1u;
}
DI void xcd_barrier(const XcdBarrier& b) {
    asm volatile("s_waitcnt vmcnt(0)" ::: "memory");
    __syncthreads();
    if (threadIdx.x == 0) {
        unsigned* bar = b.bar;
        __builtin_amdgcn_s_waitcnt(0);
        unsigned nloc = b.st[0], nx = b.st[1];
        if (nloc == 0u) { xcd_barrier_complete(bar, b.x, nloc, nx); b.st[0] = nloc; b.st[1] = nx; }
        const unsigned old = xb_add(&bar[XB_XSUB(b.x)], 1u);
        const unsigned gen = old / nloc;
        if (old + 1u == (gen + 1u) * nloc) {
            __builtin_amdgcn_fence(__ATOMIC_RELEASE, "agent");
            asm volatile("s_waitcnt vmcnt(0)" ::: "memory");
            const unsigned og = xb_add(&bar[XB_TOP], 1u);
            const unsigned tg = og / nx;
            if (og + 1u == (tg + 1u) * nx) xb_add(&bar[XB_TOPGEN], 1u);
            else XB_SPIN(xb_ld(&bar[XB_TOPGEN]) == tg, bar);
            __builtin_amdgcn_fence(__ATOMIC_ACQUIRE, "agent");
            xb_add(&bar[XB_XGEN(b.x)], 1u);
            asm volatile("s_waitcnt vmcnt(0)" ::: "memory");
        } else {
            XB_SPIN(xb_ld(&bar[XB_XGEN(b.x)]) == gen, bar);
            __builtin_amdgcn_fence(__ATOMIC_ACQUIRE, "agent");
            asm volatile("s_waitcnt vmcnt(0)" ::: "memory");
        }
    }
    __syncthreads();
}

constexpr int SMEM_BYTES = 152 * 1024;
constexpr int XB_ST_OFF = 150 * 1024;
template <bool COOP>
__global__ void __launch_bounds__(512) hybrid_fwd(Params P, int ph_lo, int ph_hi) {
    extern __shared__ __attribute__((aligned(16))) char smem[];
#ifndef PROBE_REP
#define PROBE_REP 0
#endif
    volatile LAS unsigned* xst = (volatile LAS unsigned*)(smem + XB_ST_OFF);
    if (threadIdx.x == 0) { xst[0] = 0u; xst[1] = 0u; xst[2] = 0u; xst[3] = 0u; }
    __syncthreads();
    XcdBarrier xb; xb.bar = (unsigned*)(P.ws + OFF_CTR) + 256; xb.x = 0u; xb.st = xst;
    if (COOP) xb = xcd_barrier_post((unsigned*)(P.ws + OFF_CTR) + 256, xst);
    BlkMap bm; bm.xcd = 0; bm.rank = 0; bm.cnt = 1; bm.ok = 0;
    unsigned* census = (unsigned*)(P.ws + OFF_CTR) + 16;
    if (COOP) {
        bm.xcd = (int)xcc_id() & 7;
        if (threadIdx.x == 0) *(int*)smem = (int)atomicAdd(census + bm.xcd, 1u);
        __syncthreads();
        bm.rank = __builtin_amdgcn_readfirstlane(*(int*)smem);
        __syncthreads();
    }
#define RUN_PHASE(k, call) do { if (COOP || (ph_lo <= (k) && (k) <= ph_hi)) { if (COOP && (k) == 1) cg::this_grid().sync(); else if (COOP && (k) > 1) xcd_barrier(xb); \
        if (COOP && (k) == 1) { int okk = 1; const int per = (int)gridDim.x >> 3; for (int x_ = 0; x_ < 8; ++x_) okk &= ((int)census[x_] == per); \
            bm.cnt = per; bm.ok = okk && ((gridDim.x & 7) == 0) && per == 32; } \
        call; \
        if (COOP && ((PROBE_REP >> (k)) & 1)) { cg::this_grid().sync(); if ((k) == 3) phase_attn(P, smem, 1); else { call; } } } } while (0)
    RUN_PHASE(0, phase_prep(P));
    RUN_PHASE(1, phase_inproj(P, smem, bm));
    RUN_PHASE(2, phase_mla_up(P, smem));
    RUN_PHASE(3, phase_attn(P, smem));
    RUN_PHASE(4, phase_merge(P, smem, bm));
    RUN_PHASE(5, phase_outproj(P, smem, bm));
    RUN_PHASE(6, phase_peerq(P, smem, bm));
    RUN_PHASE(8, phase_exp_u(P, bm));
    RUN_PHASE(9, phase_exp_w(P));
    RUN_PHASE(10, phase_exp_v(P, bm, smem));
    RUN_PHASE(11, phase_final_norm(P));
#undef RUN_PHASE
}

extern "C" void kernel_launch(void* const* d_in, const int* in_sizes, int n_in, void* d_out, int out_size, void* d_ws, size_t ws_size, hipStream_t stream) {
    Params p{};
    p.x = (const float*)d_in[0]; p.pos = (const int*)d_in[1]; p.mix_g = (const float*)d_in[2]; p.w_in = (const float*)d_in[3];
    p.qn_g = (const float*)d_in[4]; p.w_qup = (const float*)d_in[5]; p.kvn_g = (const float*)d_in[6]; p.w_kvup = (const float*)d_in[7];
    p.w_a = (const float*)d_in[8]; p.w_b = (const float*)d_in[9]; p.w_out = (const float*)d_in[10]; p.ffn_g = (const float*)d_in[11];
    p.w_pq = (const float*)d_in[12]; p.keys1 = (const float*)d_in[13]; p.keys2 = (const float*)d_in[14]; p.eu = (const float*)d_in[15];
    p.ev = (const float*)d_in[16]; p.fin_g = (const float*)d_in[17];
    p.out = (float*)d_out; p.ws = (char*)d_ws;
    static int grid_blocks = 0;
    if (!grid_blocks) {
        int dev = 0, cus = 0, per_cu = 0;
        hipGetDevice(&dev);
        hipDeviceGetAttribute(&cus, hipDeviceAttributeMultiprocessorCount, dev);
#if MK_COOP
        hipFuncSetAttribute((const void*)hybrid_fwd<true>, hipFuncAttributeMaxDynamicSharedMemorySize, SMEM_BYTES);
        hipOccupancyMaxActiveBlocksPerMultiprocessor(&per_cu, hybrid_fwd<true>, NTHR, SMEM_BYTES);
#else
        hipFuncSetAttribute((const void*)hybrid_fwd<false>, hipFuncAttributeMaxDynamicSharedMemorySize, SMEM_BYTES);
        hipOccupancyMaxActiveBlocksPerMultiprocessor(&per_cu, hybrid_fwd<false>, NTHR, SMEM_BYTES);
#endif
        if (per_cu < 1) per_cu = 1;
        grid_blocks = cus * per_cu;
    }
#if MK_COOP
    hipMemsetAsync((char*)d_ws + OFF_CTR, 0, CTR_MEMSET_BYTES, stream);
    int lo = 0, hi = 11;
    void* args[] = {&p, &lo, &hi};
    hipError_t e = hipLaunchCooperativeKernel((void*)hybrid_fwd<true>, dim3(grid_blocks), dim3(NTHR), args, SMEM_BYTES, stream);
    if (e != hipSuccess) fprintf(stderr, "cooperative launch failed: %s (grid %d)\n", hipGetErrorString(e), grid_blocks);
#else
    hipMemsetAsync((char*)d_ws + OFF_CTR, 0, CTR_MEMSET_BYTES, stream);
    for (int ph = 0; ph <= 11; ++ph) hipLaunchKernelGGL(hybrid_fwd<false>, dim3(grid_blocks), dim3(NTHR), SMEM_BYTES, stream, p, ph, ph);
#endif
}
```
